# Optimizing an MI355X kernel written in HIP

```python
import jax, jax.numpy as jnp
from jax import lax
import numpy as np

D_MODEL = 4096
BATCH = 1
SEQ = 16384
DEPTH = 1

D_RNN = D_MODEL
N_RNN_BLOCKS = 16
RNN_BLOCK = D_RNN // N_RNN_BLOCKS
CONV_WIDTH = 4
LRU_C = 8.0
HEAD_DIM = 64
N_Q_HEADS = 64
N_KV_HEADS = 8
GQA_GROUP = N_Q_HEADS // N_KV_HEADS
D_ATTN = N_Q_HEADS * HEAD_DIM
D_KV = N_KV_HEADS * HEAD_DIM
WINDOW = 128
BLOCK_Q = 128
EPS = 1e-6

SPLIT_SIZES = (D_RNN, D_RNN, D_ATTN, D_KV, D_KV, D_ATTN, D_MODEL, D_MODEL)
SPLIT_POINTS = (D_RNN,
                2 * D_RNN,
                2 * D_RNN + D_ATTN,
                2 * D_RNN + D_ATTN + D_KV,
                2 * D_RNN + D_ATTN + 2 * D_KV,
                2 * D_RNN + 2 * D_ATTN + 2 * D_KV,
                2 * D_RNN + 2 * D_ATTN + 2 * D_KV + D_MODEL)
D_IN = 2 * D_RNN + 2 * D_ATTN + 2 * D_KV + 2 * D_MODEL

kernel_name = "hybrid_rglru_swa_sink_adaln_block"


def rmsnorm(x, gain):
    xf = x.astype(jnp.float32)
    return xf * lax.rsqrt(jnp.mean(xf * xf, axis=-1, keepdims=True) + EPS) * gain.astype(jnp.float32)


def causal_depthwise_conv(u, w, b):
    s = u.shape[1]
    up = jnp.pad(u, ((0, 0), (CONV_WIDTH - 1, 0), (0, 0)))
    out = b
    for k in range(CONV_WIDTH):
        out = out + w[k] * up[:, k:k + s]
    return out


def rg_lru(u, w_a, b_a, w_x, b_x, lam):
    bsz, s, _ = u.shape
    uf = u.astype(jnp.float32)
    ub = uf.reshape(bsz, s, N_RNN_BLOCKS, RNN_BLOCK)
    r = jax.nn.sigmoid(jnp.einsum('bshi,hij->bshj', ub, w_a.astype(jnp.float32)) + b_a).reshape(bsz, s, D_RNN)
    i = jax.nn.sigmoid(jnp.einsum('bshi,hij->bshj', ub, w_x.astype(jnp.float32)) + b_x).reshape(bsz, s, D_RNN)
    log_a = -LRU_C * r * jax.nn.softplus(-lam.astype(jnp.float32))
    a = jnp.exp(log_a)
    b_in = jnp.sqrt(-jnp.expm1(2.0 * log_a)) * (i * uf)

    def combine(left, right):
        a1, b1 = left
        a2, b2 = right
        return a1 * a2, a2 * b1 + b2

    _, h = lax.associative_scan(combine, (a, b_in), axis=1)
    return h.astype(u.dtype)


def sliding_window_attention_with_sinks(q, k, v, sinks):
    bsz, s, _ = q.shape
    nb = s // BLOCK_Q
    qb = q.reshape(bsz, nb, BLOCK_Q, N_KV_HEADS, GQA_GROUP, HEAD_DIM)
    kb = k.reshape(bsz, nb, BLOCK_Q, N_KV_HEADS, HEAD_DIM)
    vb = v.reshape(bsz, nb, BLOCK_Q, N_KV_HEADS, HEAD_DIM)
    pad = jnp.zeros_like(kb[:, :1])
    k_band = jnp.concatenate([jnp.concatenate([pad, kb[:, :-1]], axis=1), kb], axis=2)
    v_band = jnp.concatenate([jnp.concatenate([pad, vb[:, :-1]], axis=1), vb], axis=2)
    scale = HEAD_DIM ** -0.5
    scores = jnp.einsum('bnqhgd,bnkhd->bnhgqk', qb, k_band).astype(jnp.float32) * scale
    qi = jnp.arange(BLOCK_Q)[:, None]
    kj = jnp.arange(2 * BLOCK_Q)[None, :]
    dist = qi + BLOCK_Q - kj
    in_window = (dist >= 0) & (dist < WINDOW)
    first_block = (jnp.arange(nb) == 0)[:, None, None]
    valid = in_window[None] & ~(first_block & (kj < BLOCK_Q)[None])
    scores = jnp.where(valid[None, :, None, None], scores, -jnp.inf)
    sink = sinks.astype(jnp.float32).reshape(N_KV_HEADS, GQA_GROUP)[None, None, :, :, None, None]
    m = jnp.maximum(jnp.max(scores, axis=-1, keepdims=True), sink)
    p = jnp.exp(scores - m)
    denom = jnp.sum(p, axis=-1, keepdims=True) + jnp.exp(sink - m)
    probs = (p / denom).astype(v.dtype)
    o = jnp.einsum('bnhgqk,bnkhd->bnqhgd', probs, v_band)
    return o.reshape(bsz, s, D_ATTN)


def setup_inputs(seed: int = 0) -> dict:
    key = jax.random.key(seed)
    ks = jax.random.split(key, 20)
    f32 = jnp.float32
    L = DEPTH
    x = jax.random.normal(ks[0], (BATCH, SEQ, D_MODEL), f32)
    c = jax.random.normal(ks[1], (BATCH, D_MODEL), f32)
    w_ada = jax.random.normal(ks[2], (L, D_MODEL, 3 * D_MODEL), f32) * (0.5 * D_MODEL ** -0.5)
    b_ada = 0.01 * jax.random.normal(ks[3], (L, 3 * D_MODEL), f32)
    norm_gain = 1.0 + 0.02 * jax.random.normal(ks[4], (L, D_MODEL), f32)
    w_in = jax.random.normal(ks[5], (L, D_MODEL, D_IN), f32) * D_MODEL ** -0.5
    conv_w = jax.random.normal(ks[6], (L, CONV_WIDTH, D_RNN), f32) * CONV_WIDTH ** -0.5
    conv_b = 0.01 * jax.random.normal(ks[7], (L, D_RNN), f32)
    w_gate_a = jax.random.normal(ks[8], (L, N_RNN_BLOCKS, RNN_BLOCK, RNN_BLOCK), f32) * RNN_BLOCK ** -0.5
    b_gate_a = 0.01 * jax.random.normal(ks[9], (L, N_RNN_BLOCKS, RNN_BLOCK), f32)
    w_gate_x = jax.random.normal(ks[10], (L, N_RNN_BLOCKS, RNN_BLOCK, RNN_BLOCK), f32) * RNN_BLOCK ** -0.5
    b_gate_x = 0.01 * jax.random.normal(ks[11], (L, N_RNN_BLOCKS, RNN_BLOCK), f32)
    a0 = jax.random.uniform(ks[12], (L, D_RNN), f32, minval=0.9, maxval=0.999)
    lru_lambda = jnp.log(a0) - jnp.log1p(-a0)
    attn_sinks = 0.5 * jax.random.normal(ks[13], (L, N_Q_HEADS), f32)
    w_rnn_proj = jax.random.normal(ks[14], (L, D_RNN, D_MODEL), f32) * D_RNN ** -0.5
    w_attn_proj = jax.random.normal(ks[15], (L, D_ATTN, D_MODEL), f32) * D_ATTN ** -0.5
    w_out = jax.random.normal(ks[16], (L, D_MODEL, D_MODEL), f32) * D_MODEL ** -0.5
    final_norm_gain = 1.0 + 0.02 * jax.random.normal(ks[17], (D_MODEL,), f32)
    return {"x": x, "c": c, "w_ada": w_ada, "b_ada": b_ada, "norm_gain": norm_gain,
            "w_in": w_in, "conv_w": conv_w, "conv_b": conv_b,
            "w_gate_a": w_gate_a, "b_gate_a": b_gate_a, "w_gate_x": w_gate_x, "b_gate_x": b_gate_x,
            "lru_lambda": lru_lambda, "attn_sinks": attn_sinks,
            "w_rnn_proj": w_rnn_proj, "w_attn_proj": w_attn_proj, "w_out": w_out,
            "final_norm_gain": final_norm_gain}


def reference(x, c, w_ada, b_ada, norm_gain, w_in, conv_w, conv_b, w_gate_a, b_gate_a,
              w_gate_x, b_gate_x, lru_lambda, attn_sinks, w_rnn_proj, w_attn_proj, w_out,
              final_norm_gain):
    dt = x.dtype
    c_act = jax.nn.silu(c)
    for l in range(DEPTH):
        mod = jnp.einsum('bd,de->be', c_act, w_ada[l]) + b_ada[l]
        shift, scale, gate = jnp.split(mod, 3, axis=-1)
        h = rmsnorm(x, norm_gain[l]) * (1.0 + scale[:, None, :].astype(jnp.float32)) + shift[:, None, :].astype(jnp.float32)
        h = h.astype(dt)
        proj = jnp.einsum('bsd,de->bse', h, w_in[l])
        u_rnn, g_rnn, q, k, v, g_attn, m_rnn, m_attn = jnp.split(proj, SPLIT_POINTS, axis=-1)
        u = causal_depthwise_conv(u_rnn, conv_w[l], conv_b[l])
        y_rnn = rg_lru(u, w_gate_a[l], b_gate_a[l], w_gate_x[l], b_gate_x[l], lru_lambda[l]) * jax.nn.silu(g_rnn)
        y_attn = sliding_window_attention_with_sinks(q, k, v, attn_sinks[l]) * jax.nn.silu(g_attn)
        merged = (jax.nn.sigmoid(m_rnn) * jnp.einsum('bse,ed->bsd', y_rnn, w_rnn_proj[l])
                  + jax.nn.sigmoid(m_attn) * jnp.einsum('bse,ed->bsd', y_attn, w_attn_proj[l]))
        out = jnp.einsum('bsd,de->bse', merged, w_out[l])
        x = x + gate[:, None, :] * out
    return rmsnorm(x, final_norm_gain).astype(dt)
```

```cpp
#include <hip/hip_runtime.h>
#include <cstdio>
#include <cstdint>
namespace pg8 {
#define PG8_LAS __attribute__((address_space(3)))
typedef unsigned short bf16_t;
typedef short bf16x8 __attribute__((ext_vector_type(8)));
typedef float f32x4 __attribute__((ext_vector_type(4)));
typedef unsigned u32x4 __attribute__((ext_vector_type(4)));
constexpr int BM = 256, BK = 64, HALF = 128, HTB = HALF * BK * 2  , STAGE_BYTES = 8 * HTB, NXCD = 8, WGM = 8;

__host__ __device__ __forceinline__ int lds_byte(int r, int c) { const int st = (r >> 4) * 2 + (c >> 5), rr = r & 15, cc = c & 31, ob = rr * 64 + cc * 2; return st * 1024 + (ob ^ (((ob >> 9) & 1) << 5)); }
__host__ __device__ __forceinline__ void stage_rc(int b, int& R, int& C) { const int st = b / 1024, sb = b % 1024, swz = sb ^ (((sb >> 9) & 1) << 5); R = (st >> 1) * 16 + swz / 64; C = (st & 1) * 32 + (swz % 64) / 2; }
__host__ __device__ __forceinline__ int perm32(int rho) { const int n = rho >> 4, i = rho & 15; return 8 * (i >> 2) + 4 * n + (i & 3); }

struct Unit { int pm, pn; };
struct Gemm { const bf16_t* A; const bf16_t* Bt; int M, N, K; };

struct StaticOrder {
    int nM, nN, nwg, G, c;
    __host__ __device__ void init(int M, int N, int G_, int c_) { nM = M / BM; nN = N / BM; nwg = nM * nN; G = G_; c = c_; }
    __host__ __device__ bool next(int i, Unit& u) const {
        const long L = (long)i * G + c; if (L >= nwg) return false;
        int wgid = (int)L; { const int q = nwg / NXCD, r = nwg % NXCD, xcd = wgid % NXCD, off = wgid / NXCD; wgid = (xcd < r ? xcd * (q + 1) : r * (q + 1) + (xcd - r) * q) + off; }
        const int nig = WGM * nN, gid = wgid / nig, fm = gid * WGM, gsz = (nM - fm) < WGM ? (nM - fm) : WGM;
        u.pm = fm + ((wgid % nig) % gsz); u.pn = (wgid % nig) / gsz; return true;
    }
    __device__ __forceinline__ void a_ready(const Unit&) const {}
    __device__ __forceinline__ void done(const Unit&) const {}
};

__device__ __forceinline__ unsigned cvt_pk_bf16(float lo, float hi) { unsigned r; asm volatile("v_cvt_pk_bf16_f32 %0, %1, %2" : "=v"(r) : "v"(lo), "v"(hi)); return r; }
typedef float f32x2 __attribute__((ext_vector_type(2)));

typedef __bf16 bf16x2_t __attribute__((ext_vector_type(2)));
__device__ __forceinline__ unsigned cvtpk(float lo, float hi) { f32x2 v = {lo, hi}; bf16x2_t b = __builtin_convertvector(v, bf16x2_t); return __builtin_bit_cast(unsigned, b); }
__device__ __forceinline__ float bflo(unsigned w) { return __builtin_bit_cast(float, w << 16); }
__device__ __forceinline__ float bfhi(unsigned w) { return __builtin_bit_cast(float, w & 0xffff0000u); }
__device__ __forceinline__ float sigmoid_f(float x) { return __builtin_amdgcn_rcpf(1.0f + __builtin_amdgcn_exp2f(x * -1.4426950408889634f)); }

struct EpiProj {
    static constexpr bool PERM = true, AFTER_DRAIN = false;
    bf16_t *U, *G, *Q, *K, *V, *GA, *MR, *MA; float qscale;
    __device__ __forceinline__ void operator()(const f32x4 (&acc)[2][2][4][2], const Unit& u, int wr, int wc, int fr, int fq) const {
        const int pn = u.pn; bf16_t* base; int ldc = 4096, colt, act;
        if (pn < 16) { base = U; colt = pn; act = 0; } else if (pn < 32) { base = G; colt = pn - 16; act = 1; } else if (pn < 48) { base = Q; colt = pn - 32; act = 3; }
        else if (pn < 50) { base = K; colt = pn - 48; act = 0; ldc = 512; } else if (pn < 52) { base = V; colt = pn - 50; act = 0; ldc = 512; }
        else if (pn < 68) { base = GA; colt = pn - 52; act = 1; } else if (pn < 84) { base = MR; colt = pn - 68; act = 2; } else { base = MA; colt = pn - 84; act = 2; }
        const int row0 = u.pm * BM + wr * 64 + fr, col0 = colt * BM + wc * 32 + 8 * fq;
        const float qs = qscale;
#pragma unroll
        for (int ai = 0; ai < 2; ++ai)
#pragma unroll
            for (int m = 0; m < 4; ++m) { bf16_t* rowp = base + (size_t)(row0 + ai * HALF + m * 16) * ldc + col0;
#pragma unroll
                for (int bj = 0; bj < 2; ++bj) { f32x4 v0 = acc[ai][bj][m][0], v1 = acc[ai][bj][m][1];
                    if (act == 1) {
#pragma unroll
                        for (int j = 0; j < 4; ++j) { v0[j] = v0[j] * sigmoid_f(v0[j]); v1[j] = v1[j] * sigmoid_f(v1[j]); } }
                    else if (act == 2) {
#pragma unroll
                        for (int j = 0; j < 4; ++j) { v0[j] = sigmoid_f(v0[j]); v1[j] = sigmoid_f(v1[j]); } }
                    else if (act == 3) { v0 = v0 * qs; v1 = v1 * qs; }
                    u32x4 w; w.x = cvtpk(v0[0], v0[1]); w.y = cvtpk(v0[2], v0[3]); w.z = cvtpk(v1[0], v1[1]); w.w = cvtpk(v1[2], v1[3]);
                    *(u32x4*)(rowp + bj * HALF) = w; } }
    }
};
struct EpiMrgA {
    static constexpr bool PERM = true, AFTER_DRAIN = false;
    float* T; const bf16_t* Gt;
    __device__ __forceinline__ void operator()(const f32x4 (&acc)[2][2][4][2], const Unit& u, int wr, int wc, int fr, int fq) const {
        const int row0 = u.pm * BM + wr * 64 + fr, col0 = u.pn * BM + wc * 32 + 8 * fq;
#pragma unroll
        for (int ai = 0; ai < 2; ++ai)
#pragma unroll
            for (int m = 0; m < 4; ++m) { const size_t off = (size_t)(row0 + ai * HALF + m * 16) * 4096 + col0;
#pragma unroll
                for (int bj = 0; bj < 2; ++bj) { const u32x4 g = *(const u32x4*)(Gt + off + bj * HALF); const f32x4 v0 = acc[ai][bj][m][0], v1 = acc[ai][bj][m][1];
                    f32x4 o0, o1; o0[0] = v0[0] * bflo(g.x); o0[1] = v0[1] * bfhi(g.x); o0[2] = v0[2] * bflo(g.y); o0[3] = v0[3] * bfhi(g.y);
                    o1[0] = v1[0] * bflo(g.z); o1[1] = v1[1] * bfhi(g.z); o1[2] = v1[2] * bflo(g.w); o1[3] = v1[3] * bfhi(g.w);
                    *(f32x4*)(T + off + bj * HALF) = o0; *(f32x4*)(T + off + bj * HALF + 4) = o1; } }
    }
};
struct EpiMrgB {
    static constexpr bool PERM = true, AFTER_DRAIN = false;
    const float* T; const bf16_t* Gt; bf16_t* O;
    __device__ __forceinline__ void operator()(const f32x4 (&acc)[2][2][4][2], const Unit& u, int wr, int wc, int fr, int fq) const {
        const int row0 = u.pm * BM + wr * 64 + fr, col0 = u.pn * BM + wc * 32 + 8 * fq;
#pragma unroll
        for (int ai = 0; ai < 2; ++ai)
#pragma unroll
            for (int m = 0; m < 4; ++m) { const size_t off = (size_t)(row0 + ai * HALF + m * 16) * 4096 + col0;
#pragma unroll
                for (int bj = 0; bj < 2; ++bj) { const u32x4 g = *(const u32x4*)(Gt + off + bj * HALF); const f32x4 t0 = *(const f32x4*)(T + off + bj * HALF), t1 = *(const f32x4*)(T + off + bj * HALF + 4);
                    const f32x4 v0 = acc[ai][bj][m][0], v1 = acc[ai][bj][m][1];
                    u32x4 w; w.x = cvtpk(t0[0] + v0[0] * bflo(g.x), t0[1] + v0[1] * bfhi(g.x)); w.y = cvtpk(t0[2] + v0[2] * bflo(g.y), t0[3] + v0[3] * bfhi(g.y));
                    w.z = cvtpk(t1[0] + v1[0] * bflo(g.z), t1[1] + v1[1] * bfhi(g.z)); w.w = cvtpk(t1[2] + v1[2] * bflo(g.w), t1[3] + v1[3] * bfhi(g.w));
                    *(u32x4*)(O + off + bj * HALF) = w; } }
    }
};
struct EpiOut {
    static constexpr bool PERM = true, AFTER_DRAIN = false;
    const float* X; const float* gate; float* O;
    __device__ __forceinline__ void operator()(const f32x4 (&acc)[2][2][4][2], const Unit& u, int wr, int wc, int fr, int fq) const {
        const int row0 = u.pm * BM + wr * 64 + fr, col0 = u.pn * BM + wc * 32 + 8 * fq;
        f32x4 gv[2][2];
#pragma unroll
        for (int bj = 0; bj < 2; ++bj)
#pragma unroll
            for (int n = 0; n < 2; ++n) gv[bj][n] = *(const f32x4*)(gate + col0 + bj * HALF + 4 * n);
#pragma unroll
        for (int ai = 0; ai < 2; ++ai)
#pragma unroll
            for (int m = 0; m < 4; ++m) { const size_t off = (size_t)(row0 + ai * HALF + m * 16) * 4096 + col0;
#pragma unroll
                for (int bj = 0; bj < 2; ++bj) { const f32x4 x0 = *(const f32x4*)(X + off + bj * HALF), x1 = *(const f32x4*)(X + off + bj * HALF + 4);
                    *(f32x4*)(O + off + bj * HALF) = x0 + gv[bj][0] * acc[ai][bj][m][0]; *(f32x4*)(O + off + bj * HALF + 4) = x1 + gv[bj][1] * acc[ai][bj][m][1]; } }
    }
};

template <class Epi, class Sched, bool ALIGN_EPI = false, bool SP2 = false>
__device__ __forceinline__ void gemm_phase(PG8_LAS unsigned char* lds, const Gemm g, const Sched& S, const Epi& E) {
    const int tid = threadIdx.x, wid = __builtin_amdgcn_readfirstlane(tid >> 6), lane = tid & 63, wr = wid >> 2, wc = wid & 3, fr = lane & 15, fq = lane >> 4;
    const int K = g.K, nt = K / BK;
    unsigned voffA[2], voffB[2];
#pragma unroll
    for (int i = 0; i < 2; ++i) { int R, C; stage_rc(tid * 16 + i * 8192, R, C); const int Rb = Epi::PERM ? ((R & ~31) + perm32(R & 31)) : R;
        voffA[i] = (unsigned)(R * K + C) * 2u; voffB[i] = (unsigned)(Rb * K + C) * 2u; }
    const size_t kstep = (size_t)(BK * 2);
    const size_t hstep = (size_t)HALF * K * 2;
    const size_t tstep = 2 * hstep;
    const unsigned ldsw = (unsigned)wid * 1024u;
    const int aoff = lds_byte(wr * 64 + fr, fq * 8), boff = lds_byte(wc * 32 + fr, fq * 8);
#define PG8_SA(b, h) (((b) * 2 + (h)) * HTB)
#define PG8_SB(b, h) ((4 + (b) * 2 + (h)) * HTB)
#define PG8_STAGE(bufoff, gbase, voff) do { _Pragma("unroll") for (int _i = 0; _i < 2; ++_i) \
        __builtin_amdgcn_global_load_lds((const unsigned*)((const char*)(gbase) + (voff)[_i]), (PG8_LAS unsigned*)(lds + (bufoff) + ldsw + _i * 8192), 16, 0, 0); } while (0)
#define PG8_LDA(dst, b, h) do { _Pragma("unroll") for (int m = 0; m < 4; ++m) _Pragma("unroll") for (int k = 0; k < 2; ++k) dst[m][k] = *(const PG8_LAS bf16x8*)(lds + PG8_SA(b, h) + aoff + m * 2048 + k * 1024); } while (0)
#define PG8_LDB(dst, b, h) do { _Pragma("unroll") for (int n = 0; n < 2; ++n) _Pragma("unroll") for (int k = 0; k < 2; ++k) dst[n][k] = *(const PG8_LAS bf16x8*)(lds + PG8_SB(b, h) + boff + n * 2048 + k * 1024); } while (0)
#define PG8_MMA(ai, bj, At, Bt) do { __builtin_amdgcn_s_setprio(1); _Pragma("unroll") for (int m = 0; m < 4; ++m) _Pragma("unroll") for (int n = 0; n < 2; ++n) _Pragma("unroll") for (int k = 0; k < 2; ++k) \
        acc[ai][bj][m][n] = __builtin_amdgcn_mfma_f32_16x16x32_bf16(Bt[n][k], At[m][k], acc[ai][bj][m][n], 0, 0, 0); __builtin_amdgcn_s_setprio(0); } while (0)
#define PG8_WAIT_V(n) asm volatile("s_waitcnt vmcnt(" #n ")" ::: "memory")
#define PG8_WAIT_L(n) asm volatile("s_waitcnt lgkmcnt(" #n ")" ::: "memory")
#define PG8_BAR __builtin_amdgcn_s_barrier()
#define PG8_SCHED __builtin_amdgcn_sched_barrier(0)
    Unit cur, nxt; int ui = 0;
    if (!S.next(0, cur)) return;
    f32x4 acc[2][2][4][2];
#pragma unroll
    for (int a = 0; a < 2; ++a)
#pragma unroll
        for (int b = 0; b < 2; ++b)
#pragma unroll
            for (int m = 0; m < 4; ++m)
#pragma unroll
                for (int n = 0; n < 2; ++n) acc[a][b][m][n] = (f32x4){0.f, 0.f, 0.f, 0.f};
    bf16x8 At[4][2], B0[2][2], B1[2][2];
    const char* cA = (const char*)g.A + (size_t)cur.pm * tstep; const char* cB = (const char*)g.Bt + (size_t)cur.pn * tstep;
    S.a_ready(cur);
    if constexpr (SP2) {
        PG8_STAGE(PG8_SB(0, 0), cB, voffB); PG8_STAGE(PG8_SB(0, 1), cB + hstep, voffB); PG8_STAGE(PG8_SA(0, 0), cA, voffA); PG8_STAGE(PG8_SA(0, 1), cA + hstep, voffA);
        if (wr == 1) PG8_BAR;
        PG8_WAIT_V(2); PG8_BAR;
        PG8_STAGE(PG8_SB(1, 0), cB + kstep, voffB); PG8_STAGE(PG8_SA(1, 0), cA + kstep, voffA); PG8_STAGE(PG8_SB(1, 1), cB + hstep + kstep, voffB);
        PG8_WAIT_V(6); PG8_BAR;
    } else {
        PG8_STAGE(PG8_SB(0, 0), cB, voffB); PG8_STAGE(PG8_SA(0, 0), cA, voffA); PG8_STAGE(PG8_SB(0, 1), cB + hstep, voffB); PG8_STAGE(PG8_SA(0, 1), cA + hstep, voffA);
        if (wr == 1) PG8_BAR;
        PG8_WAIT_V(4); PG8_BAR;
        PG8_STAGE(PG8_SB(1, 0), cB + kstep, voffB); PG8_STAGE(PG8_SA(1, 0), cA + kstep, voffA); PG8_STAGE(PG8_SB(1, 1), cB + hstep + kstep, voffB);
        PG8_WAIT_V(6); PG8_BAR;
    }
    for (;;) {
        const bool has_next = S.next(ui + 1, nxt);
        const char* nA = has_next ? (const char*)g.A + (size_t)nxt.pm * tstep : cA; const char* nB = has_next ? (const char*)g.Bt + (size_t)nxt.pn * tstep : cB;
        for (int t = 0; t < nt; t += 2) {
            const bool last = (t == nt - 2);
            const char* a1 = cA + (size_t)(t + 1) * kstep;
            const char* a2 = last ? nA : cA + (size_t)(t + 2) * kstep; const char* b2 = last ? nB : cB + (size_t)(t + 2) * kstep;
            const char* a3 = a2 + kstep; const char* b3 = b2 + kstep;
            if (last && has_next) S.a_ready(nxt);
            if constexpr (SP2) {
            PG8_LDB(B0, 0, 0); PG8_LDB(B1, 0, 1); PG8_SCHED; PG8_LDA(At, 0, 0); PG8_STAGE(PG8_SA(1, 1), a1 + hstep, voffA);
            PG8_WAIT_V(8); PG8_WAIT_L(0); PG8_BAR; PG8_MMA(0, 0, At, B0); PG8_MMA(0, 1, At, B1); PG8_BAR; PG8_SCHED;
            PG8_LDA(At, 0, 1); PG8_STAGE(PG8_SB(0, 0), b2, voffB); PG8_STAGE(PG8_SB(0, 1), b2 + hstep, voffB); PG8_STAGE(PG8_SA(0, 0), a2, voffA);
            PG8_WAIT_V(8); PG8_WAIT_L(0); PG8_BAR; PG8_MMA(1, 0, At, B0); PG8_MMA(1, 1, At, B1); PG8_BAR; PG8_SCHED;
            PG8_LDB(B0, 1, 0); PG8_LDB(B1, 1, 1); PG8_SCHED; PG8_LDA(At, 1, 0); PG8_STAGE(PG8_SA(0, 1), a2 + hstep, voffA);
            PG8_WAIT_V(8); PG8_WAIT_L(0); PG8_BAR; PG8_MMA(0, 0, At, B0); PG8_MMA(0, 1, At, B1); PG8_BAR; PG8_SCHED;
            PG8_LDA(At, 1, 1); PG8_STAGE(PG8_SB(1, 0), b3, voffB); PG8_STAGE(PG8_SB(1, 1), b3 + hstep, voffB); PG8_STAGE(PG8_SA(1, 0), a3, voffA);
            PG8_WAIT_V(8); PG8_WAIT_L(0); PG8_BAR; PG8_MMA(1, 0, At, B0); PG8_MMA(1, 1, At, B1); PG8_BAR; PG8_SCHED;
            } else {
            PG8_LDB(B0, 0, 0); PG8_SCHED; PG8_LDA(At, 0, 0); PG8_STAGE(PG8_SA(1, 1), a1 + hstep, voffA);
            PG8_WAIT_L(8); PG8_BAR; PG8_WAIT_L(0); PG8_MMA(0, 0, At, B0); PG8_BAR; PG8_SCHED;
            PG8_LDB(B1, 0, 1); PG8_STAGE(PG8_SB(0, 0), b2, voffB);
            PG8_BAR; PG8_WAIT_L(0); PG8_MMA(0, 1, At, B1); PG8_BAR;
            PG8_LDA(At, 0, 1); PG8_STAGE(PG8_SA(0, 0), a2, voffA);
            PG8_BAR; PG8_WAIT_L(0); PG8_MMA(1, 0, At, B0); PG8_BAR; PG8_SCHED;
            PG8_STAGE(PG8_SB(0, 1), b2 + hstep, voffB);
            PG8_WAIT_V(6); PG8_BAR; PG8_MMA(1, 1, At, B1); PG8_BAR;
            PG8_LDB(B0, 1, 0); PG8_SCHED; PG8_LDA(At, 1, 0); PG8_STAGE(PG8_SA(0, 1), a2 + hstep, voffA);
            PG8_WAIT_L(8); PG8_BAR; PG8_WAIT_L(0); PG8_MMA(0, 0, At, B0); PG8_BAR; PG8_SCHED;
            PG8_LDB(B1, 1, 1); PG8_STAGE(PG8_SB(1, 0), b3, voffB);
            PG8_BAR; PG8_WAIT_L(0); PG8_MMA(0, 1, At, B1); PG8_BAR;
            PG8_LDA(At, 1, 1); PG8_STAGE(PG8_SA(1, 0), a3, voffA);
            PG8_BAR; PG8_WAIT_L(0); PG8_MMA(1, 0, At, B0); PG8_BAR; PG8_SCHED;
            PG8_STAGE(PG8_SB(1, 1), b3 + hstep, voffB);
            PG8_WAIT_V(6); PG8_BAR; PG8_MMA(1, 1, At, B1); PG8_BAR;
            }
        }
        if constexpr (ALIGN_EPI) { if (wr == 0) PG8_BAR; }
        if constexpr (!Epi::AFTER_DRAIN) { E(acc, cur, wr, wc, fr, fq); S.done(cur); }
        if (!has_next) break;
#pragma unroll
        for (int a = 0; a < 2; ++a)
#pragma unroll
            for (int b = 0; b < 2; ++b)
#pragma unroll
                for (int m = 0; m < 4; ++m)
#pragma unroll
                    for (int n = 0; n < 2; ++n) acc[a][b][m][n] = (f32x4){0.f, 0.f, 0.f, 0.f};
        cur = nxt; cA = nA; cB = nB; ++ui;
        if constexpr (ALIGN_EPI) { if (wr == 1) PG8_BAR; }
    }
    PG8_WAIT_V(0);
    if constexpr (!ALIGN_EPI) { if (wr == 0) PG8_BAR; }
    PG8_BAR;
    if constexpr (Epi::AFTER_DRAIN) { E.fused(acc, cur, wr, wc, fr, fq, lds, wid, lane); S.done(cur); }
#undef PG8_SA
#undef PG8_SB
#undef PG8_STAGE
#undef PG8_LDA
#undef PG8_LDB
#undef PG8_MMA
#undef PG8_WAIT_V
#undef PG8_WAIT_L
#undef PG8_BAR
#undef PG8_SCHED
}
}

constexpr int NWAVES = 8;
constexpr int SEQ = 16384, DM = 4096, DIN = 25600, NQH = 64, NKVH = 8, HD = 64, DKV = 512, NCB = 16, CBW = 256;
constexpr float EPS = 1e-6f;
constexpr float LOG2E = 1.4426950408889634f;
constexpr float QSCALE = 0.125f * LOG2E;
#ifndef MK_N_LAUNCHES
#define MK_N_LAUNCHES 8
#endif
constexpr int N_PHASES = 8;
constexpr int N_LAUNCHES = MK_N_LAUNCHES;

constexpr size_t MiB = 1u << 20;
constexpr size_t WS_CTL = 0, CTL_ZERO_BYTES = 1 * MiB;
constexpr size_t WS_AGG = 1 * MiB;
constexpr size_t WS_WGA = 2 * MiB, WS_WGX = 4 * MiB;
constexpr size_t WS_WIN = 8 * MiB;
constexpr size_t WS_WRNN = 208 * MiB, WS_WATT = 240 * MiB, WS_WOUT = 272 * MiB;
constexpr size_t WS_H = 304 * MiB;
constexpr size_t WS_U = 432 * MiB, WS_G = 560 * MiB;
constexpr size_t WS_Q = 688 * MiB;
constexpr size_t WS_K = 816 * MiB, WS_V = 832 * MiB;
constexpr size_t WS_GA = 848 * MiB, WS_MR = 976 * MiB, WS_MA = 1104 * MiB;
constexpr size_t WS_MRG = 1232 * MiB;
constexpr size_t WS_END = 1360 * MiB;
constexpr size_t WS_T = WS_U;
constexpr int CW_TMO = 0, CW_CODE = 1;
constexpr int CW_BAR = 4096;
constexpr int CW_MOD = 65536;

constexpr int RING_OFF = 0, RING_BYTES = 131072;
constexpr int LDSCTL_OFF = RING_BYTES, MISC_OFF = LDSCTL_OFF + 320;
constexpr int LDS_BYTES = 147456;

#define GAS __attribute__((address_space(1)))
#define LAS __attribute__((address_space(3)))
typedef unsigned short bf16;
typedef unsigned v4u __attribute__((ext_vector_type(4)));
typedef float f32x4 __attribute__((ext_vector_type(4)));
typedef short bf16x8 __attribute__((ext_vector_type(8)));
typedef GAS unsigned gu32;
typedef GAS unsigned long long gu64;
#define RLX_AGENT __ATOMIC_RELAXED, __HIP_MEMORY_SCOPE_AGENT
#define LDS_WAIT() asm volatile("s_waitcnt lgkmcnt(0)" ::: "memory")
#define VM_WAIT() asm volatile("s_waitcnt vmcnt(0)" ::: "memory")
__device__ __forceinline__ unsigned long long rt() { return __builtin_amdgcn_s_memrealtime(); }
__device__ __forceinline__ unsigned f2bf(float f) { unsigned u = __builtin_bit_cast(unsigned, f); return (u + 0x7fffu + ((u >> 16) & 1u)) >> 16; }
__device__ __forceinline__ unsigned pk2(float lo, float hi) { return f2bf(lo) | (f2bf(hi) << 16); }

#define XB_TMO      128
#define XB_XCNT(j)  (256  + 64 * (j))
#define XB_XSUB(j)  (1280 + 64 * (j))
#define XB_XGEN(j)  (2304 + 64 * (j))
#define XB_TOP      3328
#define XB_TOPGEN   3392
#define XCD_BAR_WORDS 3456
#define XB_SPIN_CAP (1u << 18)

__device__ __forceinline__ unsigned xb_ld(unsigned* p)              { return __hip_atomic_load(p, __ATOMIC_RELAXED, __HIP_MEMORY_SCOPE_AGENT); }
__device__ __forceinline__ unsigned xb_add(unsigned* p, unsigned v) { return __hip_atomic_fetch_add(p, v, __ATOMIC_RELAXED, __HIP_MEMORY_SCOPE_AGENT); }
__device__ __forceinline__ unsigned xb_xcc_id() { return (unsigned)__builtin_amdgcn_s_getreg((3 << 11) | 20) & 0xFu; }
#define XB_SPIN(cond, bar) do { unsigned _sp = 0; while (cond) { __builtin_amdgcn_s_sleep(1); \
    if ((++_sp & 255u) == 0u) { if (xb_ld(&(bar)[XB_TMO])) break; if (_sp > XB_SPIN_CAP) { atomicAdd(&(bar)[XB_TMO], 1u); break; } } } } while (0)

struct XcdBarrier {
    unsigned* bar; unsigned x;
    volatile LAS unsigned* st;
};

__device__ __forceinline__ XcdBarrier xcd_barrier_post(unsigned* bar, volatile LAS unsigned* st) {
    XcdBarrier b; b.bar = bar; b.x = xb_xcc_id(); b.st = st;
    if (threadIdx.x == 0) (void)xb_add(&bar[XB_XCNT(b.x)], 1u);
    return b;
}
__device__ __forceinline__ void xcd_barrier_complete(unsigned* bar, unsigned x, unsigned& nloc, unsigned& nx) {
    const unsigned G = gridDim.x * gridDim.y * gridDim.z;
    unsigned sum, cnt, mine, sp = 0u;
    for (;;) {
        sum = 0u; cnt = 0u; mine = 0u;
#pragma unroll
        for (unsigned j = 0; j < 16; ++j) { const unsigned c = xb_ld(&bar[XB_XCNT(j)]); sum += c; cnt += (c > 0u) ? 1u : 0u; mine = (j == x) ? c : mine; }
        if (sum == G) break;
        __builtin_amdgcn_s_sleep(1);
        if ((++sp & 255u) == 0u) { if (xb_ld(&bar[XB_TMO])) break; if (sp > XB_SPIN_CAP) { atomicAdd(&bar[XB_TMO], 1u); break; } }
    }
    nloc = mine > 0u ? mine : 1u; nx = cnt > 0u ? cnt : 1u;
}

__device__ __forceinline__ void xcd_barrier(const XcdBarrier& b) {
    asm volatile("s_waitcnt vmcnt(0)" ::: "memory");
    __syncthreads();
    if (threadIdx.x == 0) {
        unsigned* bar = b.bar;
        __builtin_amdgcn_s_waitcnt(0);
        unsigned nloc = b.st[0], nx = b.st[1];
        if (nloc == 0u) { xcd_barrier_complete(bar, b.x, nloc, nx); b.st[0] = nloc; b.st[1] = nx; }
        const unsigned old = xb_add(&bar[XB_XSUB(b.x)], 1u);
        const unsigned gen = old / nloc;
        if (old + 1u == (gen + 1u) * nloc) {
            __builtin_amdgcn_fence(__ATOMIC_RELEASE, "agent");
            asm volatile("s_waitcnt vmcnt(0)" ::: "memory");
            const unsigned og = xb_add(&bar[XB_TOP], 1u);
            const unsigned tg = og / nx;
            if (og + 1u == (tg + 1u) * nx) xb_add(&bar[XB_TOPGEN], 1u);
            else XB_SPIN(xb_ld(&bar[XB_TOPGEN]) == tg, bar);
            __builtin_amdgcn_fence(__ATOMIC_ACQUIRE, "agent");
            xb_add(&bar[XB_XGEN(b.x)], 1u);
            asm volatile("s_waitcnt vmcnt(0)" ::: "memory");
        } else {
            XB_SPIN(xb_ld(&bar[XB_XGEN(b.x)]) == gen, bar);
            __builtin_amdgcn_fence(__ATOMIC_ACQUIRE, "agent");
            asm volatile("s_waitcnt vmcnt(0)" ::: "memory");
        }
    }
    __syncthreads();
}

typedef unsigned v2u __attribute__((ext_vector_type(2)));
typedef float f32x16 __attribute__((ext_vector_type(16)));
typedef short s16x4 __attribute__((ext_vector_type(4)));
struct Args { const float* in[18]; float* out; unsigned char* ws; int ph_lo, ph_hi; };
struct Frame {
    LAS unsigned char* lds;
    volatile LAS unsigned* MISC;
    gu32* ctl;
    int tid, lane, wave, vcu, G;
};
__device__ __forceinline__ float wave_sum(float v) {
#pragma unroll
    for (int o = 1; o < 64; o <<= 1) v += __shfl_xor(v, o);
    return v;
}
using pg8::cvtpk; using pg8::bflo; using pg8::bfhi; using pg8::sigmoid_f;

__device__ __forceinline__ void p0_transpose_item(const float* W, int K, int N, bf16* WT, LAS float* scr, int item, int lane) {
    const int nblk = N / 32, kb = item / nblk, nb = item % nblk, k0 = 64 * kb, n0 = 32 * nb;
#pragma unroll 8
    for (int i = 0; i < 32; ++i) { const int kk = 2 * i + (lane >> 5); scr[kk * 33 + (lane & 31)] = W[(size_t)(k0 + kk) * N + n0 + (lane & 31)]; }
    LDS_WAIT(); asm volatile("" ::: "memory");
    const int c = lane & 7;
#pragma unroll
    for (int j = 0; j < 4; ++j) { const int n = (lane >> 3) + 8 * j; const LAS float* s = scr + (8 * c) * 33 + n;
        v4u o; o.x = cvtpk(s[0 * 33], s[1 * 33]); o.y = cvtpk(s[2 * 33], s[3 * 33]); o.z = cvtpk(s[4 * 33], s[5 * 33]); o.w = cvtpk(s[6 * 33], s[7 * 33]);
        *(GAS v4u*)(WT + (size_t)(n0 + n) * K + k0 + 8 * c) = o; }
    LDS_WAIT(); asm volatile("" ::: "memory");
}
__device__ __forceinline__ void p0_prologue(Frame& F, const Args& a) {
    LAS float* scr = (LAS float*)(F.lds + RING_OFF + F.wave * 16384);
    const int gw = F.vcu * NWAVES + F.wave, NGW = F.G * NWAVES, lane = F.lane;
    constexpr int I_IN = (DM / 64) * (DIN / 32), I_SQ = (DM / 64) * (DM / 32), I_GT = NCB * (CBW / 64) * (CBW / 32);
    constexpr int NITEMS = I_IN + 3 * I_SQ + 2 * I_GT;
    bf16* ws16 = (bf16*)a.ws;
    for (int it = gw; it < NITEMS; it += NGW) {
        int r = it;
        if (r < I_IN) { p0_transpose_item(a.in[5], DM, DIN, (bf16*)(a.ws + WS_WIN), scr, r, lane); continue; } r -= I_IN;
        if (r < I_SQ) { p0_transpose_item(a.in[14], DM, DM, (bf16*)(a.ws + WS_WRNN), scr, r, lane); continue; } r -= I_SQ;
        if (r < I_SQ) { p0_transpose_item(a.in[15], DM, DM, (bf16*)(a.ws + WS_WATT), scr, r, lane); continue; } r -= I_SQ;
        if (r < I_SQ) { p0_transpose_item(a.in[16], DM, DM, (bf16*)(a.ws + WS_WOUT), scr, r, lane); continue; } r -= I_SQ;
        if (r < I_GT) { const int cbi = r >> 5; p0_transpose_item(a.in[8] + (size_t)cbi * 65536, CBW, CBW, (bf16*)(a.ws + WS_WGA) + (size_t)cbi * 65536, scr, r & 31, lane); continue; } r -= I_GT;
        { const int cbi = r >> 5; p0_transpose_item(a.in[10] + (size_t)cbi * 65536, CBW, CBW, (bf16*)(a.ws + WS_WGX) + (size_t)cbi * 65536, scr, r & 31, lane); }
    }
    (void)ws16;
    float* mod = (float*)(F.ctl + CW_MOD);
    for (int task = gw; task < 48 * 32; task += NGW) {
        const int ec = task % 48, ds = task / 48;
        const float c0 = a.in[1][128 * ds + lane], c1 = a.in[1][128 * ds + 64 + lane];
        const float s0 = c0 / (1.0f + __expf(-c0)), s1 = c1 / (1.0f + __expf(-c1));
        f32x4 acc = {0.f, 0.f, 0.f, 0.f};
        const GAS f32x4* wp = (const GAS f32x4*)(a.in[2] + (size_t)(128 * ds) * 12288 + 256 * ec) + lane;
#pragma unroll 8
        for (int i = 0; i < 64; ++i) { const float s = __builtin_bit_cast(float, __builtin_amdgcn_readlane(__builtin_bit_cast(int, s0), i)); acc += wp[(size_t)i * 3072] * s; }
#pragma unroll 8
        for (int i = 0; i < 64; ++i) { const float s = __builtin_bit_cast(float, __builtin_amdgcn_readlane(__builtin_bit_cast(int, s1), i)); acc += wp[(size_t)(64 + i) * 3072] * s; }
        if (ds == 0) acc += *((const GAS f32x4*)(a.in[3] + 256 * ec) + lane);
        float* mp = mod + 256 * ec + 4 * lane;
        atomicAdd(mp + 0, acc[0]); atomicAdd(mp + 1, acc[1]); atomicAdd(mp + 2, acc[2]); atomicAdd(mp + 3, acc[3]);
    }
}

__device__ __forceinline__ void p1_hrows(Frame& F, const Args& a) {
    LAS float* GS = (LAS float*)(F.lds + RING_OFF); LAS float* SH = GS + DM;
    const GAS float* mod = (const GAS float*)(F.ctl + CW_MOD);
    for (int d = F.tid; d < DM; d += NWAVES * 64) { GS[d] = a.in[4][d] * (1.0f + mod[DM + d]); SH[d] = mod[d]; }
    __syncthreads();
    const int gw = F.vcu * NWAVES + F.wave, NGW = F.G * NWAVES;
    bf16* H = (bf16*)(a.ws + WS_H);
#pragma unroll 1
    for (int m = gw; m < SEQ; m += NGW) {
        asm volatile("" ::: "memory");
        const GAS f32x4* xr = (const GAS f32x4*)(a.in[0] + (size_t)m * DM) + F.lane;
        f32x4 v[16]; float s = 0.f;
#pragma unroll
        for (int j = 0; j < 16; ++j) { v[j] = xr[64 * j]; s += (v[j].x * v[j].x + v[j].y * v[j].y) + (v[j].z * v[j].z + v[j].w * v[j].w); }
        const float rstd = 1.0f / sqrtf(wave_sum(s) * (1.0f / DM) + EPS);
        GAS v2u* o8 = (GAS v2u*)(H + (size_t)m * DM) + F.lane;
#pragma unroll
        for (int j = 0; j < 16; ++j) { const int col = 4 * F.lane + 256 * j; const f32x4 g = *(const LAS f32x4*)(GS + col), sh = *(const LAS f32x4*)(SH + col);
            const f32x4 o = v[j] * rstd * g + sh; v2u w; w.x = cvtpk(o.x, o.y); w.y = cvtpk(o.z, o.w); o8[64 * j] = w; }
    }
}

constexpr int APITCH = 528, ATILE = 64 * APITCH;
template <int PASS>
__device__ __forceinline__ void scan_pass(Frame& F, const Args& a) {
    LAS unsigned char* AT0 = F.lds + RING_OFF;
    LAS float* CW = (LAS float*)(F.lds + RING_OFF + 2 * ATILE);
    const int tid = F.tid, lane = F.lane, w = F.wave, q = lane >> 4, j = lane & 15;
    const bf16* U = (const bf16*)(a.ws + WS_U); const bf16* Gr = (const bf16*)(a.ws + WS_G); bf16* Y = (bf16*)(a.ws + WS_H);
    float* AGG = (float*)(a.ws + WS_AGG);
    const int tg = tid >> 5, cg = tid & 31;
    for (int vb = blockIdx.x; vb < 256; vb += gridDim.x) {
        const int seg = vb & 7, half = (vb >> 3) & 1, cb = vb >> 4;
        if (PASS == 1 && seg == 7) continue;
        __syncthreads();
        for (int i = tid; i < 5 * 256; i += NWAVES * 64) { const int k = i >> 8, c = i & 255; CW[i] = (k < 4) ? a.in[6][k * DM + cb * CBW + c] : a.in[7][cb * CBW + c]; }
        const int chl = half * 128 + 16 * w + j, ch = cb * CBW + chl;
        bf16x8 wa[8], wx[8];
        { const GAS bf16x8* pa = (const GAS bf16x8*)((const bf16*)(a.ws + WS_WGA) + (size_t)ch * CBW + 8 * q); const GAS bf16x8* px = (const GAS bf16x8*)((const bf16*)(a.ws + WS_WGX) + (size_t)ch * CBW + 8 * q);
#pragma unroll
          for (int kk = 0; kk < 8; ++kk) { wa[kk] = pa[4 * kk]; wx[kk] = px[4 * kk]; } }
        const float ba = a.in[9][ch], bx = a.in[11][ch];
        const float cl = -8.0f * log1pf(expf(-a.in[12][ch]));
        float c = 0.f, Ac = 1.f;
        if (PASS == 2) for (int s = 0; s < seg; ++s) { const float2 ah = *(const float2*)(AGG + ((size_t)s * DM + ch) * 2); c = ah.x * c + ah.y; }
        const int t0 = seg * 2048;
        const bf16* ucol = U + cb * CBW + 8 * cg;
        v4u R[7];
#define SCAN_LOAD(tb) do { _Pragma("unroll") for (int rr = 0; rr < 7; ++rr) { const int t = (tb) + 4 * tg - 3 + rr; R[rr] = (t >= 0) ? *(const GAS v4u*)(ucol + (size_t)t * DM) : (v4u){0u, 0u, 0u, 0u}; } } while (0)
#define SCAN_CONV(buf) do { \
            f32x4 wk[4][2]; _Pragma("unroll") for (int k = 0; k < 4; ++k) { wk[k][0] = *(const LAS f32x4*)(CW + k * 256 + 8 * cg); wk[k][1] = *(const LAS f32x4*)(CW + k * 256 + 8 * cg + 4); } \
            const f32x4 cb0 = *(const LAS f32x4*)(CW + 1024 + 8 * cg), cb1 = *(const LAS f32x4*)(CW + 1024 + 8 * cg + 4); \
            _Pragma("unroll") for (int tt = 0; tt < 4; ++tt) { f32x4 o0 = cb0, o1 = cb1; \
                _Pragma("unroll") for (int k = 0; k < 4; ++k) { const v4u x = R[tt + k]; \
                    o0 += wk[k][0] * (f32x4){bflo(x.x), bfhi(x.x), bflo(x.y), bfhi(x.y)}; o1 += wk[k][1] * (f32x4){bflo(x.z), bfhi(x.z), bflo(x.w), bfhi(x.w)}; } \
                v4u ow; ow.x = cvtpk(o0[0], o0[1]); ow.y = cvtpk(o0[2], o0[3]); ow.z = cvtpk(o1[0], o1[1]); ow.w = cvtpk(o1[2], o1[3]); \
                *(LAS v4u*)(AT0 + (buf) * ATILE + (4 * tg + tt) * APITCH + cg * 16) = ow; } } while (0)
        __syncthreads();
        SCAN_LOAD(t0); SCAN_CONV(0);
        __syncthreads();
        for (int st = 0; st < 32; ++st) {
            if (st + 1 < 32) SCAN_LOAD(t0 + 64 * (st + 1));
            const LAS unsigned char* At = AT0 + (st & 1) * ATILE;
#pragma unroll 1
            for (int wt = 0; wt < 4; ++wt) {
                const int trow = 16 * wt, tglob = t0 + 64 * st + trow + 4 * q;
                unsigned short gbits[4];
                if (PASS == 2) {
#pragma unroll
                    for (int v = 0; v < 4; ++v) gbits[v] = *(const GAS unsigned short*)(Gr + (size_t)(tglob + v) * DM + ch); }
                f32x4 accA = {0.f, 0.f, 0.f, 0.f}, accX = {0.f, 0.f, 0.f, 0.f};
#pragma unroll
                for (int kk = 0; kk < 8; ++kk) { const bf16x8 af = *(const LAS bf16x8*)(At + (trow + j) * APITCH + kk * 64 + q * 16);
                    accA = __builtin_amdgcn_mfma_f32_16x16x32_bf16(af, wa[kk], accA, 0, 0, 0); accX = __builtin_amdgcn_mfma_f32_16x16x32_bf16(af, wx[kk], accX, 0, 0, 0); }
                float av[4], bv[4];
#pragma unroll
                for (int v = 0; v < 4; ++v) {
                    const float uval = __builtin_bit_cast(float, (unsigned)(*(const LAS unsigned short*)(At + (trow + 4 * q + v) * APITCH + chl * 2)) << 16);
                    const float r = sigmoid_f(accA[v] + ba), ii = sigmoid_f(accX[v] + bx);
                    const float la = cl * r;
                    const float aa = __builtin_amdgcn_exp2f(la * LOG2E);
                    const float x2 = 2.0f * la;
                    const float om_s = -x2 * (1.0f + x2 * 0.5f * (1.0f + x2 * (1.0f / 3.0f) * (1.0f + x2 * 0.25f * (1.0f + x2 * 0.2f * (1.0f + x2 * (1.0f / 6.0f))))));
                    const float om = (x2 > -0.25f) ? om_s : (1.0f - aa * aa);
                    av[v] = aa; bv[v] = __builtin_amdgcn_sqrtf(om) * (ii * uval);
                }
                float A = av[0], Hh = bv[0];
#pragma unroll
                for (int v = 1; v < 4; ++v) { Hh = av[v] * Hh + bv[v]; A = A * av[v]; }
                { const float A1 = __shfl_up(A, 16), H1 = __shfl_up(Hh, 16); if (q >= 1) { Hh = A * H1 + Hh; A = A * A1; } }
                { const float A2 = __shfl_up(A, 32), H2 = __shfl_up(Hh, 32); if (q >= 2) { Hh = A * H2 + Hh; A = A * A2; } }
                if (PASS == 2) {
                    float Aex = __shfl_up(A, 16), Hex = __shfl_up(Hh, 16); if (q == 0) { Aex = 1.0f; Hex = 0.0f; }
                    float h = Aex * c + Hex;
#pragma unroll
                    for (int v = 0; v < 4; ++v) { h = av[v] * h + bv[v];
                        const float g = __builtin_bit_cast(float, (unsigned)gbits[v] << 16);
                        *(GAS unsigned short*)(Y + (size_t)(tglob + v) * DM + ch) = (unsigned short)(cvtpk(h * g, 0.f) & 0xffffu); }
                }
                const float At_ = __shfl(A, 48 + j), Ht_ = __shfl(Hh, 48 + j);
                c = At_ * c + Ht_; Ac = Ac * At_;
            }
            if (st + 1 < 32) SCAN_CONV((st + 1) & 1);
            __syncthreads();
        }
        if (PASS == 1 && q == 0) *(float2*)(AGG + ((size_t)seg * DM + ch) * 2) = make_float2(Ac, c);
#undef SCAN_LOAD
#undef SCAN_CONV
    }
}

constexpr int KP = 144, KBYTES = 192 * KP, ABUF = 2 * KBYTES;
__device__ __forceinline__ int crow(int reg, int h) { return (reg & 3) + 8 * (reg >> 2) + 4 * h; }
__device__ __forceinline__ void attn_phase(Frame& F, const Args& a) {
    LAS unsigned char* base = F.lds + RING_OFF;
    const int tid = F.tid, lane = F.lane, w = F.wave, r = lane & 31, hh = lane >> 5;
    const int i16 = lane & 15, q4 = i16 >> 2, p4 = i16 & 3, blk = (lane >> 4) & 1;
    bf16* Q = (bf16*)(a.ws + WS_Q); const bf16* Kg = (const bf16*)(a.ws + WS_K); const bf16* Vg = (const bf16*)(a.ws + WS_V); const bf16* GA = (const bf16*)(a.ws + WS_GA);
    constexpr int NUNITS = NKVH * (SEQ / 64);
    const int G = F.G;
    if ((int)blockIdx.x >= NUNITS) return;
    v4u pk[3], pv[3];
#define ATT_LOAD(u) do { const int hk_ = (u) >> 8, q0_ = 64 * ((u) & 255); _Pragma("unroll") for (int i = 0; i < 3; ++i) { const int p = tid + 512 * i, row = p >> 3, pc = p & 7, t = q0_ - 128 + row; \
            if (t >= 0) { pk[i] = *(const GAS v4u*)(Kg + (size_t)t * DKV + hk_ * HD + pc * 8); pv[i] = *(const GAS v4u*)(Vg + (size_t)t * DKV + hk_ * HD + pc * 8); } \
            else { pk[i] = (v4u){0u, 0u, 0u, 0u}; pv[i] = (v4u){0u, 0u, 0u, 0u}; } } } while (0)
#define ATT_WRITE(buf) do { _Pragma("unroll") for (int i = 0; i < 3; ++i) { const int p = tid + 512 * i, row = p >> 3, pc = p & 7; \
            *(LAS v4u*)(base + (buf) * ABUF + row * KP + pc * 16) = pk[i]; *(LAS v4u*)(base + (buf) * ABUF + KBYTES + row * KP + pc * 16) = pv[i]; } } while (0)
    __syncthreads();
    ATT_LOAD((int)blockIdx.x); ATT_WRITE(0);
    __syncthreads();
    for (int it = 0;; ++it) {
        const int u = it * G + (int)blockIdx.x, un = u + G; const bool has_next = un < NUNITS;
        if (has_next) ATT_LOAD(un);
        const LAS unsigned char* Kb = base + (it & 1) * ABUF; const LAS unsigned char* Vb = Kb + KBYTES;
        const int hk = u >> 8, q0 = 64 * (u & 255), head = hk * 8 + w;
        const float sink2 = a.in[13][head] * LOG2E;
#pragma unroll 1
        for (int qt = 0; qt < 2; ++qt) {
            const int q0w = q0 + 32 * qt;
            bf16x8 bq[4];
            { const GAS bf16x8* qp = (const GAS bf16x8*)(Q + (size_t)(q0w + r) * DM + head * HD + 8 * hh);
#pragma unroll
              for (int s = 0; s < 4; ++s) bq[s] = qp[2 * s]; }
            f32x16 x[5];
#pragma unroll
            for (int jt = 0; jt < 5; ++jt) {
#pragma unroll
                for (int i = 0; i < 16; ++i) x[jt][i] = 0.f;
#pragma unroll
                for (int s = 0; s < 4; ++s) { const bf16x8 kf = *(const LAS bf16x8*)(Kb + (32 * qt + 32 * jt + r) * KP + (16 * s + 8 * hh) * 2);
                    x[jt] = __builtin_amdgcn_mfma_f32_32x32x16_bf16(kf, bq[s], x[jt], 0, 0, 0); }
            }
            const int jt_min = (q0w >= 128) ? 0 : (4 - (q0w >> 5));
            const float NEG = -__builtin_inff();
            float m = sink2;
#pragma unroll
            for (int jt = 0; jt < 5; ++jt) {
#pragma unroll
                for (int i = 0; i < 16; ++i) { const int cr = crow(i, hh); bool ok = jt >= jt_min; if (jt == 0) ok = ok && (cr > r); if (jt == 4) ok = ok && (cr <= r);
                    const float v = ok ? x[jt][i] : NEG; x[jt][i] = v; m = fmaxf(m, v); }
            }
            m = fmaxf(m, __shfl_xor(m, 32));
            float l = 0.f;
#pragma unroll
            for (int jt = 0; jt < 5; ++jt) {
#pragma unroll
                for (int i = 0; i < 16; ++i) { const float p = __builtin_amdgcn_exp2f(x[jt][i] - m); x[jt][i] = p; l += p; }
            }
            l += __shfl_xor(l, 32); l += __builtin_amdgcn_exp2f(sink2 - m);
            f32x16 o[2];
#pragma unroll
            for (int i = 0; i < 16; ++i) { o[0][i] = 0.f; o[1][i] = 0.f; }
#pragma unroll
            for (int jt = 0; jt < 5; ++jt) {
#pragma unroll
                for (int s = 0; s < 2; ++s) {
                    v4u pw; pw.x = cvtpk(x[jt][8 * s + 0], x[jt][8 * s + 1]); pw.y = cvtpk(x[jt][8 * s + 2], x[jt][8 * s + 3]); pw.z = cvtpk(x[jt][8 * s + 4], x[jt][8 * s + 5]); pw.w = cvtpk(x[jt][8 * s + 6], x[jt][8 * s + 7]);
                    const bf16x8 pf = __builtin_bit_cast(bf16x8, pw);
#pragma unroll
                    for (int dt = 0; dt < 2; ++dt) {
                        const LAS unsigned char* vp = Vb + (32 * qt + 32 * jt + 16 * s + 4 * hh + q4) * KP + (32 * dt + 16 * blk) * 2 + 8 * p4;
                        const s16x4 lo = __builtin_bit_cast(s16x4, __builtin_amdgcn_ds_read_tr16_b64_v4i16((LAS s16x4*)vp));
                        const s16x4 hi = __builtin_bit_cast(s16x4, __builtin_amdgcn_ds_read_tr16_b64_v4i16((LAS s16x4*)(vp + 8 * KP)));
                        const bf16x8 vf = __builtin_shufflevector(lo, hi, 0, 1, 2, 3, 4, 5, 6, 7);
                        o[dt] = __builtin_amdgcn_mfma_f32_32x32x16_bf16(vf, pf, o[dt], 0, 0, 0);
                    }
                }
            }
            const float inv = 1.0f / l;
#pragma unroll
            for (int dt = 0; dt < 2; ++dt)
#pragma unroll
                for (int g = 0; g < 4; ++g) { const size_t idx = (size_t)(q0w + r) * DM + head * HD + 32 * dt + 8 * g + 4 * hh;
                    const v2u gg = *(const GAS v2u*)(GA + idx);
                    v2u ow; ow.x = cvtpk(o[dt][4 * g + 0] * inv * bflo(gg.x), o[dt][4 * g + 1] * inv * bfhi(gg.x)); ow.y = cvtpk(o[dt][4 * g + 2] * inv * bflo(gg.y), o[dt][4 * g + 3] * inv * bfhi(gg.y));
                    *(GAS v2u*)(Q + idx) = ow; }
        }
        if (has_next) ATT_WRITE((it + 1) & 1);
        __syncthreads();
        if (!has_next) break;
    }
#undef ATT_LOAD
#undef ATT_WRITE
}

__device__ __forceinline__ void p7_final(Frame& F, const Args& a) {
    LAS float* FG = (LAS float*)(F.lds + RING_OFF);
    for (int d = F.tid; d < DM; d += NWAVES * 64) FG[d] = a.in[17][d];
    __syncthreads();
    const int gw = F.vcu * NWAVES + F.wave, NGW = F.G * NWAVES;
#pragma unroll 1
    for (int m = gw; m < SEQ; m += NGW) {
        asm volatile("" ::: "memory");
        GAS f32x4* xr = (GAS f32x4*)(a.out + (size_t)m * DM) + F.lane;
        f32x4 v[16]; float s = 0.f;
#pragma unroll
        for (int j = 0; j < 16; ++j) { v[j] = xr[64 * j]; s += (v[j].x * v[j].x + v[j].y * v[j].y) + (v[j].z * v[j].z + v[j].w * v[j].w); }
        const float rstd = 1.0f / sqrtf(wave_sum(s) * (1.0f / DM) + EPS);
#pragma unroll
        for (int j = 0; j < 16; ++j) { const f32x4 g = *(const LAS f32x4*)(FG + 4 * F.lane + 256 * j); xr[64 * j] = v[j] * rstd * g; }
    }
}

__global__ void __launch_bounds__(NWAVES * 64, 2) fwd(Args args) {
    extern __shared__ __attribute__((aligned(16))) unsigned char lds[];
    Frame F;
    F.lds = (LAS unsigned char*)lds;
    F.MISC = (volatile LAS unsigned*)(F.lds + MISC_OFF);
    F.tid = threadIdx.x; F.lane = F.tid & 63; F.wave = __builtin_amdgcn_readfirstlane(F.tid >> 6);
    F.G = gridDim.x; { const int bx = blockIdx.x; F.vcu = (F.G % 8 == 0) ? (bx % 8) * (F.G / 8) + bx / 8 : bx; }
    F.ctl = (gu32*)(args.ws + WS_CTL);
    for (int u = F.tid; u < (LDS_BYTES - LDSCTL_OFF) / 4; u += NWAVES * 64) ((LAS unsigned*)(F.lds + LDSCTL_OFF))[u] = 0u;
    __syncthreads();
    XcdBarrier bar; bar.bar = (unsigned*)(F.ctl + CW_BAR); bar.x = 0; bar.st = nullptr;
    if (N_LAUNCHES == 1) bar = xcd_barrier_post((unsigned*)(F.ctl + CW_BAR), F.MISC + 8);
#define GRID_BAR(seam) do { if (N_LAUNCHES != 1) { if (F.tid == 0) __hip_atomic_store(F.ctl + CW_TMO, 0xBADBA0u | (unsigned)(seam), RLX_AGENT); } else { xcd_barrier(bar); } } while (0)
    const int lo = args.ph_lo, hi = args.ph_hi;
#ifndef PH_MASK
#define PH_MASK 0xff
#endif
#define IN(k) (((PH_MASK >> (k)) & 1) && lo <= (k) && (k) < hi)
#define BOTH(k) (IN(k) && IN((k) + 1))
    unsigned char* ws = args.ws;

    if (IN(0)) { p0_prologue(F, args); if (BOTH(0)) GRID_BAR(0); }
    if (IN(1)) { p1_hrows(F, args); if (BOTH(1)) GRID_BAR(1); }
    if (IN(2)) {
        __syncthreads();
        pg8::Gemm g{(const pg8::bf16_t*)(ws + WS_H), (const pg8::bf16_t*)(ws + WS_WIN), SEQ, DIN, DM}; pg8::StaticOrder S; S.init(SEQ, DIN, F.G, (int)blockIdx.x);
        pg8::EpiProj E{(pg8::bf16_t*)(ws + WS_U), (pg8::bf16_t*)(ws + WS_G), (pg8::bf16_t*)(ws + WS_Q), (pg8::bf16_t*)(ws + WS_K), (pg8::bf16_t*)(ws + WS_V), (pg8::bf16_t*)(ws + WS_GA), (pg8::bf16_t*)(ws + WS_MR), (pg8::bf16_t*)(ws + WS_MA), QSCALE};
        pg8::gemm_phase<pg8::EpiProj, pg8::StaticOrder, true, true>(F.lds + RING_OFF, g, S, E);
        if (BOTH(2)) GRID_BAR(2);
    }
    if (IN(3)) { scan_pass<1>(F, args); if (BOTH(3)) GRID_BAR(3); }
    if (IN(4)) { scan_pass<2>(F, args); attn_phase(F, args); if (BOTH(4)) GRID_BAR(4); }
    if (IN(5)) {
        __syncthreads();
        { pg8::Gemm g{(const pg8::bf16_t*)(ws + WS_H), (const pg8::bf16_t*)(ws + WS_WRNN), SEQ, DM, DM}; pg8::StaticOrder S; S.init(SEQ, DM, F.G, (int)blockIdx.x);
          pg8::EpiMrgA E{(float*)(ws + WS_T), (const pg8::bf16_t*)(ws + WS_MR)};
          pg8::gemm_phase<pg8::EpiMrgA, pg8::StaticOrder, true, true>(F.lds + RING_OFF, g, S, E); }
        VM_WAIT(); __syncthreads();
        { pg8::Gemm g{(const pg8::bf16_t*)(ws + WS_Q), (const pg8::bf16_t*)(ws + WS_WATT), SEQ, DM, DM}; pg8::StaticOrder S; S.init(SEQ, DM, F.G, (int)blockIdx.x);
          pg8::EpiMrgB E{(const float*)(ws + WS_T), (const pg8::bf16_t*)(ws + WS_MA), (pg8::bf16_t*)(ws + WS_MRG)};
          pg8::gemm_phase<pg8::EpiMrgB, pg8::StaticOrder, true, true>(F.lds + RING_OFF, g, S, E); }
        if (BOTH(5)) GRID_BAR(5);
    }
    if (IN(6)) {
        __syncthreads();
        pg8::Gemm g{(const pg8::bf16_t*)(ws + WS_MRG), (const pg8::bf16_t*)(ws + WS_WOUT), SEQ, DM, DM}; pg8::StaticOrder S; S.init(SEQ, DM, F.G, (int)blockIdx.x);
        pg8::EpiOut E{args.in[0], (const float*)(F.ctl + CW_MOD) + 2 * DM, args.out};
        pg8::gemm_phase<pg8::EpiOut, pg8::StaticOrder, true, true>(F.lds + RING_OFF, g, S, E);
        if (BOTH(6)) GRID_BAR(6);
    }
    if (IN(7)) { __syncthreads(); p7_final(F, args); }
#undef IN
#undef BOTH
}

extern "C" void kernel_launch(void* const* d_in, const int* in_sizes, int n_in, void* d_out, int out_size, void* d_ws, size_t ws_size, hipStream_t stream) {
    static int grid = 0;
    if (grid == 0) {
        if (n_in != 18 || in_sizes[0] != SEQ * DM || out_size != SEQ * DM || ws_size < WS_END) { fprintf(stderr, "kernel_launch: unexpected shapes (n_in %d, in0 %d, out %d, ws %zu); nothing launched\n", n_in, n_in > 0 ? in_sizes[0] : -1, out_size, ws_size); grid = -1; return; }
        int dev = 0, cus = 0, per_cu = 0;
        if (hipGetDevice(&dev) != hipSuccess || hipDeviceGetAttribute(&cus, hipDeviceAttributeMultiprocessorCount, dev) != hipSuccess) { grid = -1; return; }
        if (hipFuncSetAttribute((const void*)fwd, hipFuncAttributeMaxDynamicSharedMemorySize, LDS_BYTES) != hipSuccess) { fprintf(stderr, "kernel_launch: hipFuncSetAttribute failed\n"); grid = -1; return; }
        if (hipOccupancyMaxActiveBlocksPerMultiprocessor(&per_cu, (const void*)fwd, NWAVES * 64, LDS_BYTES) != hipSuccess || per_cu < 1) fprintf(stderr, "kernel_launch: note: occupancy query reports %d workgroups per CU\n", per_cu);
        (void)hipGetLastError();
        grid = cus;
    }
    if (grid < 0) return;
    if (hipMemsetAsync((char*)d_ws + WS_CTL, 0, CTL_ZERO_BYTES, stream) != hipSuccess) return;
    Args a{};
    for (int i = 0; i < 18; ++i) a.in[i] = (const float*)d_in[i];
    a.out = (float*)d_out; a.ws = (unsigned char*)d_ws;
    if (N_LAUNCHES == 1) { a.ph_lo = 0; a.ph_hi = N_PHASES; hipLaunchKernelGGL(fwd, dim3(grid), dim3(NWAVES * 64), LDS_BYTES, stream, a); }
    else for (int li = 0; li < N_PHASES; ++li) { a.ph_lo = li; a.ph_hi = li + 1; hipLaunchKernelGGL(fwd, dim3(grid), dim3(NWAVES * 64), LDS_BYTES, stream, a); }
}
```

```cpp
#define F8Q 1
#define I8A 0
#include <hip/hip_runtime.h>
#include <cstdio>
#include <cstdint>
namespace pg8 {
#define PG8_LAS __attribute__((address_space(3)))
typedef unsigned short bf16_t;
typedef short bf16x8 __attribute__((ext_vector_type(8)));
typedef float f32x4 __attribute__((ext_vector_type(4)));
typedef unsigned u32x4 __attribute__((ext_vector_type(4)));
constexpr int BM = 256, BK = 64, HALF = 128, HTB = HALF * BK * 2  , STAGE_BYTES = 8 * HTB, NXCD = 8;
#ifndef PG8_WGM
#define PG8_WGM 8
#endif
constexpr int WGM = PG8_WGM;

__host__ __device__ __forceinline__ int lds_byte(int r, int c) { const int st = (r >> 4) * 2 + (c >> 5), rr = r & 15, cc = c & 31, ob = rr * 64 + cc * 2; return st * 1024 + (ob ^ (((ob >> 9) & 1) << 5)); }
__host__ __device__ __forceinline__ void stage_rc(int b, int& R, int& C) { const int st = b / 1024, sb = b % 1024, swz = sb ^ (((sb >> 9) & 1) << 5); R = (st >> 1) * 16 + swz / 64; C = (st & 1) * 32 + (swz % 64) / 2; }
__host__ __device__ __forceinline__ int perm32(int rho) { const int n = rho >> 4, i = rho & 15; return 8 * (i >> 2) + 4 * n + (i & 3); }

__host__ __device__ __forceinline__ int f8_slot(int pn, unsigned mask) {
    int slot = 0; const int nmr = (int)((mask >> 8) & 31u);
    const int mr_hi = nmr ? 68 + nmr : 84; const int nu = (int)((mask >> 13) & 31u), u_hi = nu ? nu : 16, ng = (int)((mask >> 18) & 31u), g_hi = ng ? 16 + ng : 32;
#define F8_SEG(s, lo, hi) if (pn < (hi)) return ((mask >> (s)) & 1u) ? slot + pn - (lo) : -1; if ((mask >> (s)) & 1u) slot += (hi) - (lo);
    F8_SEG(0, 0, u_hi) F8_SEG(7, u_hi, 16) F8_SEG(1, 16, g_hi) F8_SEG(7, g_hi, 32) F8_SEG(2, 32, 48) F8_SEG(3, 48, 52) F8_SEG(4, 52, 68) F8_SEG(5, 68, mr_hi) F8_SEG(7, mr_hi, 84) F8_SEG(6, 84, 100)
#undef F8_SEG
    return -1;
}
__host__ __device__ __forceinline__ int f8_tile(int slot, unsigned mask) {
    const int nmr = (int)((mask >> 8) & 31u), mr_hi = nmr ? 68 + nmr : 84, nu = (int)((mask >> 13) & 31u), u_hi = nu ? nu : 16, ng = (int)((mask >> 18) & 31u), g_hi = ng ? 16 + ng : 32;
#define F8_SEG(s, lo, hi) if ((mask >> (s)) & 1u) { if (slot < (hi) - (lo)) return (lo) + slot; slot -= (hi) - (lo); }
    F8_SEG(0, 0, u_hi) F8_SEG(1, 16, g_hi) F8_SEG(2, 32, 48) F8_SEG(3, 48, 52) F8_SEG(4, 52, 68) F8_SEG(5, 68, mr_hi) F8_SEG(6, 84, 100)
#undef F8_SEG
    return -1;
}
__host__ __device__ constexpr int f8_count(unsigned mask) {
    const int nmr = (int)((mask >> 8) & 31u), mr_hi = nmr ? 68 + nmr : 84, nu = (int)((mask >> 13) & 31u), u_hi = nu ? nu : 16, ng = (int)((mask >> 18) & 31u), g_hi = ng ? 16 + ng : 32; int c = 0;
#define F8_SEG(s, lo, hi) if ((mask >> (s)) & 1u) c += (hi) - (lo);
    F8_SEG(0, 0, u_hi) F8_SEG(1, 16, g_hi) F8_SEG(2, 32, 48) F8_SEG(3, 48, 52) F8_SEG(4, 52, 68) F8_SEG(5, 68, mr_hi) F8_SEG(6, 84, 100)
#undef F8_SEG
    return c;
}
struct Unit { int pm, pn; };
struct Gemm { const bf16_t* A; const bf16_t* Bt; int M, N, K; int ld = 0; int amask = 0x7fffffff, bmask = 0x7fffffff; const unsigned char* A8 = nullptr; const unsigned char* B8 = nullptr; unsigned f8_mask = 0u; };

struct StaticOrder {
    int nM, nN, nwg, G, c;
    __host__ __device__ void init(int M, int N, int G_, int c_) { nM = M / BM; nN = N / BM; nwg = nM * nN; G = G_; c = c_; }
    __host__ __device__ bool next(int i, Unit& u) const {
        const long L = (long)i * G + c; if (L >= nwg) return false;
        int wgid = (int)L; { const int q = nwg / NXCD, r = nwg % NXCD, xcd = wgid % NXCD, off = wgid / NXCD; wgid = (xcd < r ? xcd * (q + 1) : r * (q + 1) + (xcd - r) * q) + off; }
        const int nig = WGM * nN, gid = wgid / nig, fm = gid * WGM, gsz = (nM - fm) < WGM ? (nM - fm) : WGM;
        u.pm = fm + ((wgid % nig) % gsz); u.pn = (wgid % nig) / gsz; return true;
    }
    __device__ __forceinline__ void a_ready(const Unit&) const {}
    __device__ __forceinline__ void done(const Unit&) const {}
};

__device__ __forceinline__ unsigned cvt_pk_bf16(float lo, float hi) { unsigned r; asm volatile("v_cvt_pk_bf16_f32 %0, %1, %2" : "=v"(r) : "v"(lo), "v"(hi)); return r; }
typedef float f32x2 __attribute__((ext_vector_type(2)));

typedef __bf16 bf16x2_t __attribute__((ext_vector_type(2)));
typedef unsigned u32x2e __attribute__((ext_vector_type(2)));
#ifndef GATE_U8
#define GATE_U8 0
#endif
__device__ __forceinline__ float ub(unsigned w, int k) { return (float)((w >> (8 * k)) & 0xffu); }
__device__ __forceinline__ unsigned cvtpk(float lo, float hi) { f32x2 v = {lo, hi}; bf16x2_t b = __builtin_convertvector(v, bf16x2_t); return __builtin_bit_cast(unsigned, b); }
__device__ __forceinline__ float bflo(unsigned w) { return __builtin_bit_cast(float, w << 16); }
__device__ __forceinline__ float bfhi(unsigned w) { return __builtin_bit_cast(float, w & 0xffff0000u); }
__device__ __forceinline__ float sigmoid_f(float x) { return __builtin_amdgcn_rcpf(1.0f + __builtin_amdgcn_exp2f(x * -1.4426950408889634f)); }

typedef int i32x4e __attribute__((ext_vector_type(4)));
struct EpiProj {
    static constexpr bool PERM = true, AFTER_DRAIN = false, HAS_MID = false;
    bf16_t *U, *G, *Q, *K, *V, *GA, *MR, *MA; float qscale; float f8inv = 1.0f; unsigned f8_mask = 0u; const float* RS = nullptr; const float* CS = nullptr; const float* BIAS = nullptr;
    __device__ __forceinline__ void operator()(const f32x4 (&acc)[2][2][4][2], const Unit& u, int wr, int wc, int fr, int fq) const {
        const int pn = u.pn; bf16_t* base; int ldc = 4096, colt, act;
        if (pn < 16) { base = U; colt = pn; act = 0; } else if (pn < 32) { base = G; colt = pn - 16; act = 1; } else if (pn < 48) { base = Q; colt = pn - 32; act = 3; }
        else if (pn < 50) { base = K; colt = pn - 48; act = 0; ldc = 512; } else if (pn < 52) { base = V; colt = pn - 50; act = 0; ldc = 512; }
        else if (pn < 68) { base = GA; colt = pn - 52; act = 1; } else if (pn < 84) { base = MR; colt = pn - 68; act = 2; } else { base = MA; colt = pn - 84; act = 2; }
        const int row0 = u.pm * BM + wr * 64 + fr, col0 = colt * BM + wc * 32 + 8 * fq;
        const bool lowp = f8_slot(pn, f8_mask) >= 0, isq = lowp && RS != nullptr;
        const float pre = (lowp && !isq) ? f8inv : 1.0f, qs = qscale * pre;
        float rsv[2][4]; f32x4 csv[2][2], bsv[2][2];
        if (isq) {
            const int gc0 = pn * BM + wc * 32 + 8 * fq;
#pragma unroll
            for (int ai = 0; ai < 2; ++ai)
#pragma unroll
                for (int m = 0; m < 4; ++m) rsv[ai][m] = RS[row0 + ai * HALF + m * 16];
#pragma unroll
            for (int bj = 0; bj < 2; ++bj)
#pragma unroll
                for (int n = 0; n < 2; ++n) { csv[bj][n] = *(const f32x4*)(CS + gc0 + bj * HALF + 4 * n); bsv[bj][n] = *(const f32x4*)(BIAS + gc0 + bj * HALF + 4 * n); }
        } else {
#pragma unroll
            for (int ai = 0; ai < 2; ++ai)
#pragma unroll
                for (int m = 0; m < 4; ++m) rsv[ai][m] = 0.f;
#pragma unroll
            for (int bj = 0; bj < 2; ++bj)
#pragma unroll
                for (int n = 0; n < 2; ++n) { csv[bj][n] = (f32x4){0.f, 0.f, 0.f, 0.f}; bsv[bj][n] = (f32x4){0.f, 0.f, 0.f, 0.f}; }
        }
#pragma unroll
        for (int ai = 0; ai < 2; ++ai)
#pragma unroll
            for (int m = 0; m < 4; ++m) { bf16_t* rowp = base + (size_t)(row0 + ai * HALF + m * 16) * ldc + col0;
#pragma unroll
                for (int bj = 0; bj < 2; ++bj) { f32x4 v0 = acc[ai][bj][m][0], v1 = acc[ai][bj][m][1];
                    if (isq) {
                        const i32x4e i0 = __builtin_bit_cast(i32x4e, v0), i1 = __builtin_bit_cast(i32x4e, v1);
#pragma unroll
                        for (int j = 0; j < 4; ++j) { v0[j] = (float)i0[j] * (rsv[ai][m] * csv[bj][0][j]) + bsv[bj][0][j]; v1[j] = (float)i1[j] * (rsv[ai][m] * csv[bj][1][j]) + bsv[bj][1][j]; } }
                    else if (act == 1 || act == 2) { v0 = v0 * pre; v1 = v1 * pre; }
                    if (act == 1) {
#pragma unroll
                        for (int j = 0; j < 4; ++j) { v0[j] = v0[j] * sigmoid_f(v0[j]); v1[j] = v1[j] * sigmoid_f(v1[j]); } }
                    else if (act == 2) {
#pragma unroll
                        for (int j = 0; j < 4; ++j) { v0[j] = fmaxf(sigmoid_f(v0[j]), 1e-30f); v1[j] = fmaxf(sigmoid_f(v1[j]), 1e-30f); } }
                    else if (act == 3) { v0 = v0 * qs; v1 = v1 * qs; }
#if GATE_U8
                    if (act == 2) {
                        unsigned lo = 0u, hi = 0u;
#pragma unroll
                        for (int j = 0; j < 4; ++j) { lo |= (unsigned)fminf(fmaxf(__builtin_rintf(v0[j] * 255.0f), 1.0f), 255.0f) << (8 * j); hi |= (unsigned)fminf(fmaxf(__builtin_rintf(v1[j] * 255.0f), 1.0f), 255.0f) << (8 * j); }
                        *(u32x2e*)((unsigned char*)base + (size_t)(row0 + ai * HALF + m * 16) * ldc + col0 + bj * HALF) = (u32x2e){lo, hi}; continue; }
#endif
                    u32x4 w; w.x = cvtpk(v0[0], v0[1]); w.y = cvtpk(v0[2], v0[3]); w.z = cvtpk(v1[0], v1[1]); w.w = cvtpk(v1[2], v1[3]);
                    *(u32x4*)(rowp + bj * HALF) = w; } }
    }
};
#if GATE_U8
struct EpiMerge {
    static constexpr bool PERM = true, AFTER_DRAIN = false, HAS_MID = true;
    const bf16_t* Gr; const bf16_t* Ga; bf16_t* O;
    __device__ __forceinline__ void mid(f32x4 (&acc)[2][2][4][2], const Unit& u, int wr, int wc, int fr, int fq) const {
        int opq; asm volatile("v_mov_b32 %0, 0" : "=v"(opq));
        const int row0 = u.pm * BM + wr * 64 + fr + opq, col0 = u.pn * BM + wc * 32 + 8 * fq;
        const unsigned char* R8 = (const unsigned char*)Gr; const unsigned char* A8 = (const unsigned char*)Ga;
        u32x2e gr[2][4][2], ga[2][4][2];
#pragma unroll
        for (int ai = 0; ai < 2; ++ai)
#pragma unroll
            for (int m = 0; m < 4; ++m)
#pragma unroll
                for (int bj = 0; bj < 2; ++bj) { const size_t off = (size_t)(row0 + ai * HALF + m * 16) * 4096 + col0 + bj * HALF; gr[ai][m][bj] = *(const u32x2e*)(R8 + off); ga[ai][m][bj] = *(const u32x2e*)(A8 + off); }
        __builtin_amdgcn_sched_barrier(0);
#pragma unroll
        for (int ai = 0; ai < 2; ++ai)
#pragma unroll
            for (int m = 0; m < 4; ++m)
#pragma unroll
                for (int bj = 0; bj < 2; ++bj) { const u32x2e r = gr[ai][m][bj], a = ga[ai][m][bj]; f32x4 s0, s1;
#pragma unroll
                    for (int j = 0; j < 4; ++j) { s0[j] = ub(r.x, j) * __builtin_amdgcn_rcpf(ub(a.x, j)); s1[j] = ub(r.y, j) * __builtin_amdgcn_rcpf(ub(a.y, j)); }
                    acc[ai][bj][m][0] *= s0; acc[ai][bj][m][1] *= s1; }
        __builtin_amdgcn_sched_barrier(0);
    }
    __device__ __forceinline__ void operator()(const f32x4 (&acc)[2][2][4][2], const Unit& u, int wr, int wc, int fr, int fq) const {
        const int row0 = u.pm * BM + wr * 64 + fr, col0 = u.pn * BM + wc * 32 + 8 * fq;
        const unsigned char* A8 = (const unsigned char*)Ga;
        u32x2e ga[2][4][2];
#pragma unroll
        for (int ai = 0; ai < 2; ++ai)
#pragma unroll
            for (int m = 0; m < 4; ++m)
#pragma unroll
                for (int bj = 0; bj < 2; ++bj) ga[ai][m][bj] = *(const u32x2e*)(A8 + (size_t)(row0 + ai * HALF + m * 16) * 4096 + col0 + bj * HALF);
        __builtin_amdgcn_sched_barrier(0);
        const float k = 1.0f / 255.0f;
#pragma unroll
        for (int ai = 0; ai < 2; ++ai)
#pragma unroll
            for (int m = 0; m < 4; ++m)
#pragma unroll
                for (int bj = 0; bj < 2; ++bj) { const u32x2e g = ga[ai][m][bj]; const f32x4 v0 = acc[ai][bj][m][0] * k, v1 = acc[ai][bj][m][1] * k;
                    u32x4 w; w.x = cvtpk(v0[0] * ub(g.x, 0), v0[1] * ub(g.x, 1)); w.y = cvtpk(v0[2] * ub(g.x, 2), v0[3] * ub(g.x, 3)); w.z = cvtpk(v1[0] * ub(g.y, 0), v1[1] * ub(g.y, 1)); w.w = cvtpk(v1[2] * ub(g.y, 2), v1[3] * ub(g.y, 3));
                    *(u32x4*)(O + (size_t)(row0 + ai * HALF + m * 16) * 4096 + col0 + bj * HALF) = w; }
    }
};
#else
template <bool I8FIRST>
struct EpiMergeT {
    static constexpr bool PERM = true, AFTER_DRAIN = false, HAS_MID = true;
    const bf16_t* Gr; const bf16_t* Ga; bf16_t* O; const float* RS2 = nullptr; const float* CS2 = nullptr;
    __device__ __forceinline__ void mid(f32x4 (&acc)[2][2][4][2], const Unit& u, int wr, int wc, int fr, int fq) const {
        int opq; asm volatile("v_mov_b32 %0, 0" : "=v"(opq));
        const int row0 = u.pm * BM + wr * 64 + fr + opq, col0 = u.pn * BM + wc * 32 + 8 * fq + opq;
        if (I8FIRST) {
            f32x4 cs[2][2];
#pragma unroll
            for (int bj = 0; bj < 2; ++bj)
#pragma unroll
                for (int n = 0; n < 2; ++n) cs[bj][n] = *(const f32x4*)(CS2 + col0 + bj * HALF + 4 * n);
#pragma unroll
            for (int ai = 0; ai < 2; ++ai)
#pragma unroll
                for (int m = 0; m < 4; ++m) { const float rs = RS2[row0 + ai * HALF + m * 16];
#pragma unroll
                    for (int bj = 0; bj < 2; ++bj)
#pragma unroll
                        for (int n = 0; n < 2; ++n) { const i32x4e iv = __builtin_bit_cast(i32x4e, acc[ai][bj][m][n]);
#pragma unroll
                            for (int j = 0; j < 4; ++j) acc[ai][bj][m][n][j] = (float)iv[j] * (rs * cs[bj][n][j]);
                            asm volatile("" : "+v"(acc[ai][bj][m][n])); } }
            __builtin_amdgcn_sched_barrier(0); asm volatile("" ::: "memory");
        }
#pragma unroll
        for (int ai = 0; ai < 2; ++ai)
#pragma unroll
        for (int mh = 0; mh < 1; ++mh) {
            const int mlo = 0, mhi = 4;
            u32x4 gr[4][2], ga[4][2];
#pragma unroll
            for (int m = 0; m < 4; ++m) if (m >= mlo && m < mhi)
#pragma unroll
                for (int bj = 0; bj < 2; ++bj) { const size_t off = (size_t)(row0 + ai * HALF + m * 16) * 4096 + col0 + bj * HALF; gr[m][bj] = *(const u32x4*)(Gr + off); ga[m][bj] = *(const u32x4*)(Ga + off); }
            __builtin_amdgcn_sched_barrier(0);
#pragma unroll
            for (int m = 0; m < 4; ++m) if (m >= mlo && m < mhi)
#pragma unroll
                for (int bj = 0; bj < 2; ++bj) { const u32x4 r = gr[m][bj], a = ga[m][bj]; f32x4 s0, s1;
                    s0[0] = bflo(r.x) * __builtin_amdgcn_rcpf(bflo(a.x)); s0[1] = bfhi(r.x) * __builtin_amdgcn_rcpf(bfhi(a.x)); s0[2] = bflo(r.y) * __builtin_amdgcn_rcpf(bflo(a.y)); s0[3] = bfhi(r.y) * __builtin_amdgcn_rcpf(bfhi(a.y));
                    s1[0] = bflo(r.z) * __builtin_amdgcn_rcpf(bflo(a.z)); s1[1] = bfhi(r.z) * __builtin_amdgcn_rcpf(bfhi(a.z)); s1[2] = bflo(r.w) * __builtin_amdgcn_rcpf(bflo(a.w)); s1[3] = bfhi(r.w) * __builtin_amdgcn_rcpf(bfhi(a.w));
                    acc[ai][bj][m][0] *= s0; acc[ai][bj][m][1] *= s1; if (I8FIRST) { asm volatile("" : "+v"(acc[ai][bj][m][0])); asm volatile("" : "+v"(acc[ai][bj][m][1])); } }
            __builtin_amdgcn_sched_barrier(0); if (I8FIRST) asm volatile("" ::: "memory");
        }
    }
    __device__ __forceinline__ void operator()(const f32x4 (&acc)[2][2][4][2], const Unit& u, int wr, int wc, int fr, int fq) const {
        const int row0 = u.pm * BM + wr * 64 + fr, col0 = u.pn * BM + wc * 32 + 8 * fq;
        u32x4 ga[2][4][2];
#pragma unroll
        for (int ai = 0; ai < 2; ++ai)
#pragma unroll
            for (int m = 0; m < 4; ++m)
#pragma unroll
                for (int bj = 0; bj < 2; ++bj) ga[ai][m][bj] = *(const u32x4*)(Ga + (size_t)(row0 + ai * HALF + m * 16) * 4096 + col0 + bj * HALF);
        __builtin_amdgcn_sched_barrier(0);
#pragma unroll
        for (int ai = 0; ai < 2; ++ai)
#pragma unroll
            for (int m = 0; m < 4; ++m)
#pragma unroll
                for (int bj = 0; bj < 2; ++bj) { const u32x4 g = ga[ai][m][bj]; const f32x4 v0 = acc[ai][bj][m][0], v1 = acc[ai][bj][m][1];
                    u32x4 w; w.x = cvtpk(v0[0] * bflo(g.x), v0[1] * bfhi(g.x)); w.y = cvtpk(v0[2] * bflo(g.y), v0[3] * bfhi(g.y)); w.z = cvtpk(v1[0] * bflo(g.z), v1[1] * bfhi(g.z)); w.w = cvtpk(v1[2] * bflo(g.w), v1[3] * bfhi(g.w));
                    *(u32x4*)(O + (size_t)(row0 + ai * HALF + m * 16) * 4096 + col0 + bj * HALF) = w; }
    }
};
using EpiMerge = EpiMergeT<false>;
#endif
struct EpiOut {
    static constexpr bool PERM = true, AFTER_DRAIN = false, HAS_MID = false;
    const float* gate; bf16_t* O;
    __device__ __forceinline__ void operator()(const f32x4 (&acc)[2][2][4][2], const Unit& u, int wr, int wc, int fr, int fq) const {
        const int row0 = u.pm * BM + wr * 64 + fr, col0 = u.pn * BM + wc * 32 + 8 * fq;
        f32x4 gv[2][2];
#pragma unroll
        for (int bj = 0; bj < 2; ++bj)
#pragma unroll
            for (int n = 0; n < 2; ++n) gv[bj][n] = *(const f32x4*)(gate + col0 + bj * HALF + 4 * n);
#pragma unroll
        for (int ai = 0; ai < 2; ++ai)
#pragma unroll
            for (int m = 0; m < 4; ++m) { const size_t off = (size_t)(row0 + ai * HALF + m * 16) * 4096 + col0;
#pragma unroll
                for (int bj = 0; bj < 2; ++bj) { const f32x4 v0 = gv[bj][0] * acc[ai][bj][m][0], v1 = gv[bj][1] * acc[ai][bj][m][1];
                    u32x4 w; w.x = cvtpk(v0[0], v0[1]); w.y = cvtpk(v0[2], v0[3]); w.z = cvtpk(v1[0], v1[1]); w.w = cvtpk(v1[2], v1[3]);
                    *(u32x4*)(O + off + bj * HALF) = w; } }
    }
};

struct EpiDummy {
    static constexpr bool PERM = true, AFTER_DRAIN = false, HAS_MID = false;
    bf16_t* O;
    __device__ __forceinline__ void operator()(const f32x4 (&acc)[2][2][4][2], const Unit& u, int wr, int wc, int fr, int fq) const {
        const int row0 = u.pm * BM + wr * 64 + fr, col0 = wc * 32 + 8 * fq;
#pragma unroll
        for (int ai = 0; ai < 2; ++ai)
#pragma unroll
            for (int m = 0; m < 4; ++m) { bf16_t* rowp = O + (size_t)(row0 + ai * HALF + m * 16) * 256 + col0;
#pragma unroll
                for (int bj = 0; bj < 2; ++bj) { const f32x4 v0 = acc[ai][bj][m][0], v1 = acc[ai][bj][m][1];
                    u32x4 w; w.x = cvtpk(v0[0], v0[1]); w.y = cvtpk(v0[2], v0[3]); w.z = cvtpk(v1[0], v1[1]); w.w = cvtpk(v1[2], v1[3]);
                    *(u32x4*)(rowp + bj * HALF) = w; } }
    }
};
template <class Epi, class Sched, bool ALIGN_EPI = false, bool SP2 = false>
__device__ __forceinline__ void gemm_phase(PG8_LAS unsigned char* lds, const Gemm g, const Sched& S, const Epi& E) {
    const int tid = threadIdx.x, wid = __builtin_amdgcn_readfirstlane(tid >> 6), lane = tid & 63, wr = wid >> 2, wc = wid & 3, fr = lane & 15, fq = lane >> 4;
    const int nt = g.K / BK, K = g.ld ? g.ld : g.K;
    unsigned voffA[2], voffB[2];
#pragma unroll
    for (int i = 0; i < 2; ++i) { int R, C; stage_rc(tid * 16 + i * 8192, R, C); const int Rb = Epi::PERM ? ((R & ~31) + perm32(R & 31)) : R;
        voffA[i] = (unsigned)(R * K + C) * 2u; voffB[i] = (unsigned)(Rb * K + C) * 2u; }
    const size_t kstep = (size_t)(BK * 2);
    const size_t hstep = (size_t)HALF * K * 2;
    const size_t tstep = 2 * hstep;
    const unsigned ldsw = (unsigned)wid * 1024u;
    const int aoff = lds_byte(wr * 64 + fr, fq * 8), boff = lds_byte(wc * 32 + fr, fq * 8);
#define PG8_SA(b, h) (((b) * 2 + (h)) * HTB)
#define PG8_SB(b, h) ((4 + (b) * 2 + (h)) * HTB)
#define PG8_STAGE(bufoff, gbase, voff) do { _Pragma("unroll") for (int _i = 0; _i < 2; ++_i) \
        __builtin_amdgcn_global_load_lds((const unsigned*)((const char*)(gbase) + (voff)[_i]), (PG8_LAS unsigned*)(lds + (bufoff) + ldsw + _i * 8192), 16, 0, 0); } while (0)
#define PG8_LDA(dst, b, h) do { _Pragma("unroll") for (int m = 0; m < 4; ++m) _Pragma("unroll") for (int k = 0; k < 2; ++k) dst[m][k] = *(const PG8_LAS bf16x8*)(lds + PG8_SA(b, h) + aoff + m * 2048 + k * 1024); } while (0)
#define PG8_LDB(dst, b, h) do { _Pragma("unroll") for (int n = 0; n < 2; ++n) _Pragma("unroll") for (int k = 0; k < 2; ++k) dst[n][k] = *(const PG8_LAS bf16x8*)(lds + PG8_SB(b, h) + boff + n * 2048 + k * 1024); } while (0)
#define PG8_MMA(ai, bj, At, Bt) do { __builtin_amdgcn_s_setprio(1); _Pragma("unroll") for (int m = 0; m < 4; ++m) _Pragma("unroll") for (int n = 0; n < 2; ++n) _Pragma("unroll") for (int k = 0; k < 2; ++k) \
        acc[ai][bj][m][n] = __builtin_amdgcn_mfma_f32_16x16x32_bf16(Bt[n][k], At[m][k], acc[ai][bj][m][n], 0, 0, 0); __builtin_amdgcn_s_setprio(0); } while (0)
#define PG8_WAIT_V(n) asm volatile("s_waitcnt vmcnt(" #n ")" ::: "memory")
#define PG8_WAIT_L(n) asm volatile("s_waitcnt lgkmcnt(" #n ")" ::: "memory")
#define PG8_BAR __builtin_amdgcn_s_barrier()
#define PG8_SCHED __builtin_amdgcn_sched_barrier(0)
    Unit cur, nxt; int ui = 0;
    if (!S.next(0, cur)) return;
    f32x4 acc[2][2][4][2];
#pragma unroll
    for (int a = 0; a < 2; ++a)
#pragma unroll
        for (int b = 0; b < 2; ++b)
#pragma unroll
            for (int m = 0; m < 4; ++m)
#pragma unroll
                for (int n = 0; n < 2; ++n) acc[a][b][m][n] = (f32x4){0.f, 0.f, 0.f, 0.f};
    bf16x8 At[4][2], B0[2][2], B1[2][2];
    const char* cA = (const char*)g.A + (size_t)(cur.pm & g.amask) * tstep; const char* cB = (const char*)g.Bt + (size_t)(cur.pn & g.bmask) * tstep;
    S.a_ready(cur);
    if constexpr (SP2) {
        PG8_STAGE(PG8_SB(0, 0), cB, voffB); PG8_STAGE(PG8_SB(0, 1), cB + hstep, voffB); PG8_STAGE(PG8_SA(0, 0), cA, voffA); PG8_STAGE(PG8_SA(0, 1), cA + hstep, voffA);
        if (wr == 1) PG8_BAR;
        PG8_WAIT_V(2); PG8_BAR;
        PG8_STAGE(PG8_SB(1, 0), cB + kstep, voffB); PG8_STAGE(PG8_SA(1, 0), cA + kstep, voffA); PG8_STAGE(PG8_SB(1, 1), cB + hstep + kstep, voffB);
        PG8_WAIT_V(6); PG8_BAR;
    } else {
        PG8_STAGE(PG8_SB(0, 0), cB, voffB); PG8_STAGE(PG8_SA(0, 0), cA, voffA); PG8_STAGE(PG8_SB(0, 1), cB + hstep, voffB); PG8_STAGE(PG8_SA(0, 1), cA + hstep, voffA);
        if (wr == 1) PG8_BAR;
        PG8_WAIT_V(4); PG8_BAR;
        PG8_STAGE(PG8_SB(1, 0), cB + kstep, voffB); PG8_STAGE(PG8_SA(1, 0), cA + kstep, voffA); PG8_STAGE(PG8_SB(1, 1), cB + hstep + kstep, voffB);
        PG8_WAIT_V(6); PG8_BAR;
    }
    for (;;) {
        const bool has_next = S.next(ui + 1, nxt);
        const char* nA = has_next ? (const char*)g.A + (size_t)(nxt.pm & g.amask) * tstep : cA; const char* nB = has_next ? (const char*)g.Bt + (size_t)(nxt.pn & g.bmask) * tstep : cB;
        for (int t = 0; t < nt; t += 2) {
            const bool last = (t == nt - 2);
            const char* a1 = cA + (size_t)(t + 1) * kstep;
            const char* a2 = last ? nA : cA + (size_t)(t + 2) * kstep; const char* b2 = last ? nB : cB + (size_t)(t + 2) * kstep;
            const char* a3 = a2 + kstep; const char* b3 = b2 + kstep;
            if (last && has_next) S.a_ready(nxt);
            if constexpr (Epi::HAS_MID) { if (t == (nt >> 1)) {
                if (wr == 0) PG8_BAR; E.mid(acc, cur, wr, wc, fr, fq); if (wr == 1) PG8_BAR; } }
            if constexpr (SP2) {
            PG8_LDB(B0, 0, 0); PG8_LDB(B1, 0, 1); PG8_SCHED; PG8_LDA(At, 0, 0); PG8_STAGE(PG8_SA(1, 1), a1 + hstep, voffA);
            PG8_WAIT_V(8); PG8_WAIT_L(0); PG8_BAR; PG8_MMA(0, 0, At, B0); PG8_MMA(0, 1, At, B1); PG8_BAR; PG8_SCHED;
            PG8_LDA(At, 0, 1); PG8_STAGE(PG8_SB(0, 0), b2, voffB); PG8_STAGE(PG8_SB(0, 1), b2 + hstep, voffB); PG8_STAGE(PG8_SA(0, 0), a2, voffA);
            PG8_WAIT_V(8); PG8_WAIT_L(0); PG8_BAR; PG8_MMA(1, 0, At, B0); PG8_MMA(1, 1, At, B1); PG8_BAR; PG8_SCHED;
            PG8_LDB(B0, 1, 0); PG8_LDB(B1, 1, 1); PG8_SCHED; PG8_LDA(At, 1, 0); PG8_STAGE(PG8_SA(0, 1), a2 + hstep, voffA);
            PG8_WAIT_V(8); PG8_WAIT_L(0); PG8_BAR; PG8_MMA(0, 0, At, B0); PG8_MMA(0, 1, At, B1); PG8_BAR; PG8_SCHED;
            PG8_LDA(At, 1, 1); PG8_STAGE(PG8_SB(1, 0), b3, voffB); PG8_STAGE(PG8_SB(1, 1), b3 + hstep, voffB); PG8_STAGE(PG8_SA(1, 0), a3, voffA);
            PG8_WAIT_V(8); PG8_WAIT_L(0); PG8_BAR; PG8_MMA(1, 0, At, B0); PG8_MMA(1, 1, At, B1); PG8_BAR; PG8_SCHED;
            } else {
            PG8_LDB(B0, 0, 0); PG8_SCHED; PG8_LDA(At, 0, 0); PG8_STAGE(PG8_SA(1, 1), a1 + hstep, voffA);
            PG8_WAIT_L(8); PG8_BAR; PG8_WAIT_L(0); PG8_MMA(0, 0, At, B0); PG8_BAR; PG8_SCHED;
            PG8_LDB(B1, 0, 1); PG8_STAGE(PG8_SB(0, 0), b2, voffB);
            PG8_BAR; PG8_WAIT_L(0); PG8_MMA(0, 1, At, B1); PG8_BAR;
            PG8_LDA(At, 0, 1); PG8_STAGE(PG8_SA(0, 0), a2, voffA);
            PG8_BAR; PG8_WAIT_L(0); PG8_MMA(1, 0, At, B0); PG8_BAR; PG8_SCHED;
            PG8_STAGE(PG8_SB(0, 1), b2 + hstep, voffB);
            PG8_WAIT_V(6); PG8_BAR; PG8_MMA(1, 1, At, B1); PG8_BAR;
            PG8_LDB(B0, 1, 0); PG8_SCHED; PG8_LDA(At, 1, 0); PG8_STAGE(PG8_SA(0, 1), a2 + hstep, voffA);
            PG8_WAIT_L(8); PG8_BAR; PG8_WAIT_L(0); PG8_MMA(0, 0, At, B0); PG8_BAR; PG8_SCHED;
            PG8_LDB(B1, 1, 1); PG8_STAGE(PG8_SB(1, 0), b3, voffB);
            PG8_BAR; PG8_WAIT_L(0); PG8_MMA(0, 1, At, B1); PG8_BAR;
            PG8_LDA(At, 1, 1); PG8_STAGE(PG8_SA(1, 0), a3, voffA);
            PG8_BAR; PG8_WAIT_L(0); PG8_MMA(1, 0, At, B0); PG8_BAR; PG8_SCHED;
            PG8_STAGE(PG8_SB(1, 1), b3 + hstep, voffB);
            PG8_WAIT_V(6); PG8_BAR; PG8_MMA(1, 1, At, B1); PG8_BAR;
            }
        }
        if constexpr (ALIGN_EPI) { if (wr == 0) PG8_BAR; }
        if constexpr (!Epi::AFTER_DRAIN) { E(acc, cur, wr, wc, fr, fq); S.done(cur); }
        if (!has_next) break;
#pragma unroll
        for (int a = 0; a < 2; ++a)
#pragma unroll
            for (int b = 0; b < 2; ++b)
#pragma unroll
                for (int m = 0; m < 4; ++m)
#pragma unroll
                    for (int n = 0; n < 2; ++n) acc[a][b][m][n] = (f32x4){0.f, 0.f, 0.f, 0.f};
        cur = nxt; cA = nA; cB = nB; ++ui;
        if constexpr (ALIGN_EPI) { if (wr == 1) PG8_BAR; }
    }
    PG8_WAIT_V(0);
    if constexpr (!ALIGN_EPI) { if (wr == 0) PG8_BAR; }
    PG8_BAR;
    if constexpr (Epi::AFTER_DRAIN) { E.fused(acc, cur, wr, wc, fr, fq, lds, wid, lane); S.done(cur); }
#undef PG8_SA
#undef PG8_SB
#undef PG8_STAGE
#undef PG8_LDA
#undef PG8_LDB
#undef PG8_MMA
#undef PG8_WAIT_V
#undef PG8_WAIT_L
#undef PG8_BAR
#undef PG8_SCHED
}
typedef int i32x4v __attribute__((ext_vector_type(4)));
typedef int i32x8v __attribute__((ext_vector_type(8)));
__device__ __forceinline__ bf16x8 bfl8(const i32x8v& v) { const i32x4v t = __builtin_shufflevector(v, v, 0, 1, 2, 3); return __builtin_bit_cast(bf16x8, t); }
__device__ __forceinline__ bf16x8 bfh8(const i32x8v& v) { const i32x4v t = __builtin_shufflevector(v, v, 4, 5, 6, 7); return __builtin_bit_cast(bf16x8, t); }
__device__ __forceinline__ i32x4v i4l8(const i32x8v& v) { return __builtin_shufflevector(v, v, 0, 1, 2, 3); }
__device__ __forceinline__ i32x4v i4h8(const i32x8v& v) { return __builtin_shufflevector(v, v, 4, 5, 6, 7); }
__device__ __forceinline__ i32x8v cat8(const bf16x8& lo, const bf16x8& hi) { return __builtin_shufflevector(__builtin_bit_cast(i32x4v, lo), __builtin_bit_cast(i32x4v, hi), 0, 1, 2, 3, 4, 5, 6, 7); }
template <class Epi, class Sched, bool I8 = false>
__device__ __forceinline__ void gemm_phase_mixed(PG8_LAS unsigned char* lds, const Gemm g, const Sched& S, const Epi& E) {
    const int tid = threadIdx.x, wid = __builtin_amdgcn_readfirstlane(tid >> 6), lane = tid & 63, wr = wid >> 2, wc = wid & 3, fr = lane & 15, fq = lane >> 4;
    const int nt = g.K / BK, K = g.K;
    unsigned voffA[2], voffB[2];
#pragma unroll
    for (int i = 0; i < 2; ++i) { int R, C; stage_rc(tid * 16 + i * 8192, R, C); const int Rb = Epi::PERM ? ((R & ~31) + perm32(R & 31)) : R;
        voffA[i] = (unsigned)(R * K + C) * 2u; voffB[i] = (unsigned)(Rb * K + C) * 2u; }
    const size_t kstep = (size_t)(BK * 2);
    const size_t hstep = (size_t)HALF * K * 2;
    const size_t tstep = 2 * hstep;
    const unsigned ldsw = (unsigned)wid * 1024u;
    const int aoff = lds_byte(wr * 64 + fr, fq * 8), boff = lds_byte(wc * 32 + fr, fq * 8);
    const int sc1 = 0x7f7f7f7f;
#define PG8_SA(b, h) (((b) * 2 + (h)) * HTB)
#define PG8_SB(b, h) ((4 + (b) * 2 + (h)) * HTB)
#define PG8_STAGE(bufoff, gbase, voff) do { _Pragma("unroll") for (int _i = 0; _i < 2; ++_i) \
        __builtin_amdgcn_global_load_lds((const unsigned*)((const char*)(gbase) + (voff)[_i]), (PG8_LAS unsigned*)(lds + (bufoff) + ldsw + _i * 8192), 16, 0, 0); } while (0)
#define PG8_LDA(dst, b, h) do { _Pragma("unroll") for (int m = 0; m < 4; ++m) { dst[m].lo = *(const PG8_LAS i32x4v*)(lds + PG8_SA(b, h) + aoff + m * 2048); dst[m].hi = *(const PG8_LAS i32x4v*)(lds + PG8_SA(b, h) + aoff + m * 2048 + 1024); } } while (0)
#define PG8_LDB(dst, b, h) do { _Pragma("unroll") for (int n = 0; n < 2; ++n) { dst[n].lo = *(const PG8_LAS i32x4v*)(lds + PG8_SB(b, h) + boff + n * 2048); dst[n].hi = *(const PG8_LAS i32x4v*)(lds + PG8_SB(b, h) + boff + n * 2048 + 1024); } } while (0)
#define PG8_MMA16(ai, bj, At, Bt) do { __builtin_amdgcn_s_setprio(1); _Pragma("unroll") for (int m = 0; m < 4; ++m) _Pragma("unroll") for (int n = 0; n < 2; ++n) { \
            acc[ai][bj][m][n] = __builtin_amdgcn_mfma_f32_16x16x32_bf16(bfl8(Bt[n]), bfl8(At[m]), acc[ai][bj][m][n], 0, 0, 0); \
            acc[ai][bj][m][n] = __builtin_amdgcn_mfma_f32_16x16x32_bf16(bfh8(Bt[n]), bfh8(At[m]), acc[ai][bj][m][n], 0, 0, 0); } \
        __builtin_amdgcn_s_setprio(0); } while (0)
#define PG8_MMA8(ai, bj, At, Bt) do { __builtin_amdgcn_s_setprio(1); _Pragma("unroll") for (int m = 0; m < 4; ++m) _Pragma("unroll") for (int n = 0; n < 2; ++n) \
            asm volatile("v_mfma_scale_f32_16x16x128_f8f6f4 %0, %1, %2, %0, %3, %3 op_sel_hi:[0,0,0]" : "+v"(acc[ai][bj][m][n]) : "v"(Bt[n]), "v"(At[m]), "v"(sc1)); \
        __builtin_amdgcn_s_setprio(0); } while (0)
#define PG8_MMAI8(ai, bj, At, Bt) do { __builtin_amdgcn_s_setprio(1); _Pragma("unroll") for (int m = 0; m < 4; ++m) _Pragma("unroll") for (int n = 0; n < 2; ++n) { \
            acc[ai][bj][m][n] = __builtin_bit_cast(f32x4, __builtin_amdgcn_mfma_i32_16x16x64_i8(i4l8(Bt[n]), i4l8(At[m]), __builtin_bit_cast(i32x4v, acc[ai][bj][m][n]), 0, 0, 0)); \
            acc[ai][bj][m][n] = __builtin_bit_cast(f32x4, __builtin_amdgcn_mfma_i32_16x16x64_i8(i4h8(Bt[n]), i4h8(At[m]), __builtin_bit_cast(i32x4v, acc[ai][bj][m][n]), 0, 0, 0)); } \
        __builtin_amdgcn_s_setprio(0); } while (0)
#define PG8_WAIT_V(n) asm volatile("s_waitcnt vmcnt(" #n ")" ::: "memory")
#define PG8_WAIT_L(n) asm volatile("s_waitcnt lgkmcnt(" #n ")" ::: "memory")
#define PG8_BAR __builtin_amdgcn_s_barrier()
#define PG8_SCHED __builtin_amdgcn_sched_barrier(0)
#define PG8_UNIT(u, f8_, pA_, pB_) do { const int sl_ = f8_slot((u).pn, g.f8_mask); f8_ = sl_ >= 0; \
        pA_ = (f8_ ? (const char*)g.A8 : (const char*)g.A) + (size_t)(u).pm * tstep; \
        pB_ = f8_ ? (const char*)g.B8 + (size_t)sl_ * tstep : (const char*)g.Bt + (size_t)(u).pn * tstep; } while (0)
#define PG8_KLOOP(ntu, MMA_) do { \
        for (int t = 0; t < (ntu); t += 2) { \
            const bool last = (t == (ntu) - 2); \
            const char* a1 = cA + (size_t)(t + 1) * kstep; \
            const char* a2 = last ? nA : cA + (size_t)(t + 2) * kstep; const char* b2 = last ? nB : cB + (size_t)(t + 2) * kstep; \
            const char* a3 = a2 + kstep; const char* b3 = b2 + kstep; \
            PG8_LDB(B0, 0, 0); PG8_LDB(B1, 0, 1); PG8_SCHED; PG8_LDA(At, 0, 0); PG8_STAGE(PG8_SA(1, 1), a1 + hstep, voffA); \
            PG8_WAIT_V(8); PG8_WAIT_L(0); PG8_BAR; MMA_(0, 0, At, B0); MMA_(0, 1, At, B1); PG8_BAR; PG8_SCHED; \
            PG8_LDA(At, 0, 1); PG8_STAGE(PG8_SB(0, 0), b2, voffB); PG8_STAGE(PG8_SB(0, 1), b2 + hstep, voffB); PG8_STAGE(PG8_SA(0, 0), a2, voffA); \
            PG8_WAIT_V(8); PG8_WAIT_L(0); PG8_BAR; MMA_(1, 0, At, B0); MMA_(1, 1, At, B1); PG8_BAR; PG8_SCHED; \
            PG8_LDB(B0, 1, 0); PG8_LDB(B1, 1, 1); PG8_SCHED; PG8_LDA(At, 1, 0); PG8_STAGE(PG8_SA(0, 1), a2 + hstep, voffA); \
            PG8_WAIT_V(8); PG8_WAIT_L(0); PG8_BAR; MMA_(0, 0, At, B0); MMA_(0, 1, At, B1); PG8_BAR; PG8_SCHED; \
            PG8_LDA(At, 1, 1); PG8_STAGE(PG8_SB(1, 0), b3, voffB); PG8_STAGE(PG8_SB(1, 1), b3 + hstep, voffB); PG8_STAGE(PG8_SA(1, 0), a3, voffA); \
            PG8_WAIT_V(8); PG8_WAIT_L(0); PG8_BAR; MMA_(1, 0, At, B0); MMA_(1, 1, At, B1); PG8_BAR; PG8_SCHED; \
        } } while (0)
    Unit cur, nxt; int ui = 0;
    if (!S.next(0, cur)) return;
    f32x4 acc[2][2][4][2];
#pragma unroll
    for (int a = 0; a < 2; ++a)
#pragma unroll
        for (int b = 0; b < 2; ++b)
#pragma unroll
            for (int m = 0; m < 4; ++m)
#pragma unroll
                for (int n = 0; n < 2; ++n) acc[a][b][m][n] = (f32x4){0.f, 0.f, 0.f, 0.f};
    i32x8v At[4], B0[2], B1[2];
    bool f8c, f8n = false; const char *cA, *cB, *nA, *nB;
    PG8_UNIT(cur, f8c, cA, cB);
    S.a_ready(cur);
    PG8_STAGE(PG8_SB(0, 0), cB, voffB); PG8_STAGE(PG8_SB(0, 1), cB + hstep, voffB); PG8_STAGE(PG8_SA(0, 0), cA, voffA); PG8_STAGE(PG8_SA(0, 1), cA + hstep, voffA);
    if (wr == 1) PG8_BAR;
    PG8_WAIT_V(2); PG8_BAR;
    PG8_STAGE(PG8_SB(1, 0), cB + kstep, voffB); PG8_STAGE(PG8_SA(1, 0), cA + kstep, voffA); PG8_STAGE(PG8_SB(1, 1), cB + hstep + kstep, voffB);
    PG8_WAIT_V(6); PG8_BAR;
    for (;;) {
        const bool has_next = S.next(ui + 1, nxt);
        if (has_next) { PG8_UNIT(nxt, f8n, nA, nB); } else { nA = cA; nB = cB; }
        if (f8c) { if constexpr (I8) { PG8_KLOOP(nt >> 1, PG8_MMAI8); } else { PG8_KLOOP(nt >> 1, PG8_MMA8); asm volatile("s_nop 15\n\ts_nop 15" ::: "memory"); } }
        else PG8_KLOOP(nt, PG8_MMA16);
        if (wr == 0) PG8_BAR;
        E(acc, cur, wr, wc, fr, fq); S.done(cur);
        if (!has_next) break;
#pragma unroll
        for (int a = 0; a < 2; ++a)
#pragma unroll
            for (int b = 0; b < 2; ++b)
#pragma unroll
                for (int m = 0; m < 4; ++m)
#pragma unroll
                    for (int n = 0; n < 2; ++n) acc[a][b][m][n] = (f32x4){0.f, 0.f, 0.f, 0.f};
        cur = nxt; cA = nA; cB = nB; f8c = f8n; ++ui;
        if (wr == 1) PG8_BAR;
    }
    PG8_WAIT_V(0);
    PG8_BAR;
#undef PG8_UNIT
#undef PG8_KLOOP
#undef PG8_SA
#undef PG8_SB
#undef PG8_STAGE
#undef PG8_LDA
#undef PG8_LDB
#undef PG8_MMA16
#undef PG8_MMA8
#undef PG8_MMAI8
#undef PG8_WAIT_V
#undef PG8_WAIT_L
#undef PG8_BAR
#undef PG8_SCHED
}
template <class Epi, class Sched>
__device__ __forceinline__ void gemm_phase_split(PG8_LAS unsigned char* lds, const Gemm g, const Sched& S, const Epi& E, const int ki, const int kb, const size_t off8) {
    const int tid = threadIdx.x, wid = __builtin_amdgcn_readfirstlane(tid >> 6), lane = tid & 63, wr = wid >> 2, wc = wid & 3, fr = lane & 15, fq = lane >> 4;
    const int nt = g.K / BK, K = g.K;
    unsigned voffA[2], voffB[2];
#pragma unroll
    for (int i = 0; i < 2; ++i) { int R, C; stage_rc(tid * 16 + i * 8192, R, C); const int Rb = Epi::PERM ? ((R & ~31) + perm32(R & 31)) : R;
        voffA[i] = (unsigned)(R * K + C) * 2u; voffB[i] = (unsigned)(Rb * K + C) * 2u; }
    const size_t kstep = (size_t)(BK * 2);
    const size_t hstep = (size_t)HALF * K * 2;
    const size_t tstep = 2 * hstep;
    const unsigned ldsw = (unsigned)wid * 1024u;
    const int aoff = lds_byte(wr * 64 + fr, fq * 8), boff = lds_byte(wc * 32 + fr, fq * 8);
    const int sc1 = 0x7f7f7f7f;
#define PG8_SA(b, h) (((b) * 2 + (h)) * HTB)
#define PG8_SB(b, h) ((4 + (b) * 2 + (h)) * HTB)
#define PG8_STAGE(bufoff, gbase, voff) do { _Pragma("unroll") for (int _i = 0; _i < 2; ++_i) \
        __builtin_amdgcn_global_load_lds((const unsigned*)((const char*)(gbase) + (voff)[_i]), (PG8_LAS unsigned*)(lds + (bufoff) + ldsw + _i * 8192), 16, 0, 0); } while (0)
#define PG8_LDA(dst, b, h) do { _Pragma("unroll") for (int m = 0; m < 4; ++m) { dst[m].lo = *(const PG8_LAS i32x4v*)(lds + PG8_SA(b, h) + aoff + m * 2048); dst[m].hi = *(const PG8_LAS i32x4v*)(lds + PG8_SA(b, h) + aoff + m * 2048 + 1024); } } while (0)
#define PG8_LDB(dst, b, h) do { _Pragma("unroll") for (int n = 0; n < 2; ++n) { dst[n].lo = *(const PG8_LAS i32x4v*)(lds + PG8_SB(b, h) + boff + n * 2048); dst[n].hi = *(const PG8_LAS i32x4v*)(lds + PG8_SB(b, h) + boff + n * 2048 + 1024); } } while (0)
#define PG8_MMA16(ai, bj, At, Bt) do { __builtin_amdgcn_s_setprio(1); _Pragma("unroll") for (int m = 0; m < 4; ++m) _Pragma("unroll") for (int n = 0; n < 2; ++n) { \
            acc[ai][bj][m][n] = __builtin_amdgcn_mfma_f32_16x16x32_bf16(bfl8(Bt[n]), bfl8(At[m]), acc[ai][bj][m][n], 0, 0, 0); \
            acc[ai][bj][m][n] = __builtin_amdgcn_mfma_f32_16x16x32_bf16(bfh8(Bt[n]), bfh8(At[m]), acc[ai][bj][m][n], 0, 0, 0); } \
        __builtin_amdgcn_s_setprio(0); } while (0)
#define PG8_MMA8(ai, bj, At, Bt) do { __builtin_amdgcn_s_setprio(1); _Pragma("unroll") for (int m = 0; m < 4; ++m) _Pragma("unroll") for (int n = 0; n < 2; ++n) \
            asm volatile("v_mfma_scale_f32_16x16x128_f8f6f4 %0, %1, %2, %0, %3, %3 op_sel_hi:[0,0,0]" : "+v"(acc[ai][bj][m][n]) : "v"(Bt[n]), "v"(At[m]), "v"(sc1)); \
        __builtin_amdgcn_s_setprio(0); } while (0)
#define PG8_MMAI8(ai, bj, At, Bt) do { __builtin_amdgcn_s_setprio(1); _Pragma("unroll") for (int m = 0; m < 4; ++m) _Pragma("unroll") for (int n = 0; n < 2; ++n) { \
            acc[ai][bj][m][n] = __builtin_bit_cast(f32x4, __builtin_amdgcn_mfma_i32_16x16x64_i8(i4l8(Bt[n]), i4l8(At[m]), __builtin_bit_cast(i32x4v, acc[ai][bj][m][n]), 0, 0, 0)); \
            acc[ai][bj][m][n] = __builtin_bit_cast(f32x4, __builtin_amdgcn_mfma_i32_16x16x64_i8(i4h8(Bt[n]), i4h8(At[m]), __builtin_bit_cast(i32x4v, acc[ai][bj][m][n]), 0, 0, 0)); } \
        __builtin_amdgcn_s_setprio(0); } while (0)
#define PG8_WAIT_V(n) asm volatile("s_waitcnt vmcnt(" #n ")" ::: "memory")
#define PG8_WAIT_L(n) asm volatile("s_waitcnt lgkmcnt(" #n ")" ::: "memory")
#define PG8_BAR __builtin_amdgcn_s_barrier()
#define PG8_SCHED __builtin_amdgcn_sched_barrier(0)
#define PG8_UNIT(u, f8_, pA_, pB_) do { const int sl_ = f8_slot((u).pn, g.f8_mask); f8_ = sl_ >= 0; \
        pA_ = (f8_ ? (const char*)g.A8 : (const char*)g.A) + (size_t)(u).pm * tstep; \
        pB_ = f8_ ? (const char*)g.B8 + (size_t)sl_ * tstep : (const char*)g.Bt + (size_t)(u).pn * tstep; } while (0)
#define PG8_KLOOP(ntu, MMA_) do { \
        for (int t = 0; t < (ntu); t += 2) { \
            const bool last = (t == (ntu) - 2); \
            const char* a1 = cA + (size_t)(t + 1) * kstep; \
            const char* a2 = last ? nA : cA + (size_t)(t + 2) * kstep; const char* b2 = last ? nB : cB + (size_t)(t + 2) * kstep; \
            const char* a3 = a2 + kstep; const char* b3 = b2 + kstep; \
            PG8_LDB(B0, 0, 0); PG8_LDB(B1, 0, 1); PG8_SCHED; PG8_LDA(At, 0, 0); PG8_STAGE(PG8_SA(1, 1), a1 + hstep, voffA); \
            PG8_WAIT_V(8); PG8_WAIT_L(0); PG8_BAR; MMA_(0, 0, At, B0); MMA_(0, 1, At, B1); PG8_BAR; PG8_SCHED; \
            PG8_LDA(At, 0, 1); PG8_STAGE(PG8_SB(0, 0), b2, voffB); PG8_STAGE(PG8_SB(0, 1), b2 + hstep, voffB); PG8_STAGE(PG8_SA(0, 0), a2, voffA); \
            PG8_WAIT_V(8); PG8_WAIT_L(0); PG8_BAR; MMA_(1, 0, At, B0); MMA_(1, 1, At, B1); PG8_BAR; PG8_SCHED; \
            PG8_LDB(B0, 1, 0); PG8_LDB(B1, 1, 1); PG8_SCHED; PG8_LDA(At, 1, 0); PG8_STAGE(PG8_SA(0, 1), a2 + hstep, voffA); \
            PG8_WAIT_V(8); PG8_WAIT_L(0); PG8_BAR; MMA_(0, 0, At, B0); MMA_(0, 1, At, B1); PG8_BAR; PG8_SCHED; \
            PG8_LDA(At, 1, 1); PG8_STAGE(PG8_SB(1, 0), b3, voffB); PG8_STAGE(PG8_SB(1, 1), b3 + hstep, voffB); PG8_STAGE(PG8_SA(1, 0), a3, voffA); \
            PG8_WAIT_V(8); PG8_WAIT_L(0); PG8_BAR; MMA_(1, 0, At, B0); MMA_(1, 1, At, B1); PG8_BAR; PG8_SCHED; \
        } } while (0)
    Unit cur, nxt; int ui = 0;
    if (!S.next(0, cur)) return;
    f32x4 acc[2][2][4][2];
#pragma unroll
    for (int a = 0; a < 2; ++a)
#pragma unroll
        for (int b = 0; b < 2; ++b)
#pragma unroll
            for (int m = 0; m < 4; ++m)
#pragma unroll
                for (int n = 0; n < 2; ++n) acc[a][b][m][n] = (f32x4){0.f, 0.f, 0.f, 0.f};
    i32x8v At[4], B0[2], B1[2];
    const char *uA = (const char*)g.A + (size_t)cur.pm * tstep, *uB = (const char*)g.Bt + (size_t)cur.pn * tstep;
    const char *cA = uA + off8, *cB = uB + off8, *nA, *nB;
    S.a_ready(cur);
    PG8_STAGE(PG8_SB(0, 0), cB, voffB); PG8_STAGE(PG8_SB(0, 1), cB + hstep, voffB); PG8_STAGE(PG8_SA(0, 0), cA, voffA); PG8_STAGE(PG8_SA(0, 1), cA + hstep, voffA);
    if (wr == 1) PG8_BAR;
    PG8_WAIT_V(2); PG8_BAR;
    PG8_STAGE(PG8_SB(1, 0), cB + kstep, voffB); PG8_STAGE(PG8_SA(1, 0), cA + kstep, voffA); PG8_STAGE(PG8_SB(1, 1), cB + hstep + kstep, voffB);
    PG8_WAIT_V(6); PG8_BAR;
    for (;;) {
        const bool has_next = S.next(ui + 1, nxt);
        cA = uA + off8; cB = uB + off8; nA = uA; nB = uB;
        PG8_KLOOP(ki, PG8_MMAI8);
        if (wr == 0) PG8_BAR; E.mid(acc, cur, wr, wc, fr, fq); if (wr == 1) PG8_BAR;
        const char *vA = uA, *vB = uB;
        if (has_next) { vA = (const char*)g.A + (size_t)nxt.pm * tstep; vB = (const char*)g.Bt + (size_t)nxt.pn * tstep; }
        cA = uA; cB = uB; nA = vA + off8; nB = vB + off8;
        PG8_KLOOP(kb, PG8_MMA16);
        if (wr == 0) PG8_BAR;
        E(acc, cur, wr, wc, fr, fq); S.done(cur);
        if (!has_next) break;
#pragma unroll
        for (int a = 0; a < 2; ++a)
#pragma unroll
            for (int b = 0; b < 2; ++b)
#pragma unroll
                for (int m = 0; m < 4; ++m)
#pragma unroll
                    for (int n = 0; n < 2; ++n) acc[a][b][m][n] = (f32x4){0.f, 0.f, 0.f, 0.f};
        cur = nxt; uA = vA; uB = vB; ++ui;
        if (wr == 1) PG8_BAR;
    }
    PG8_WAIT_V(0);
    PG8_BAR;
#undef PG8_UNIT
#undef PG8_KLOOP
#undef PG8_SA
#undef PG8_SB
#undef PG8_STAGE
#undef PG8_LDA
#undef PG8_LDB
#undef PG8_MMA16
#undef PG8_MMA8
#undef PG8_MMAI8
#undef PG8_WAIT_V
#undef PG8_WAIT_L
#undef PG8_BAR
#undef PG8_SCHED
}
}


constexpr int NWAVES = 8;
constexpr int SEQ = 16384, DM = 4096, DIN = 25600, NQH = 64, NKVH = 8, HD = 64, DKV = 512, NCB = 16, CBW = 256;
constexpr float EPS = 1e-6f;
constexpr float LOG2E = 1.4426950408889634f;
constexpr float QSCALE = 0.125f * LOG2E;
#ifndef MK_N_LAUNCHES
#define MK_N_LAUNCHES 1
#endif
constexpr int N_PHASES = 8;
constexpr int N_LAUNCHES = MK_N_LAUNCHES;

constexpr size_t MiB = 1u << 20;
constexpr size_t WS_CTL = 0, CTL_ZERO_BYTES = 1 * MiB;
constexpr size_t WS_AGG = 6 * MiB;
constexpr size_t WS_WGA = 2 * MiB, WS_WGX = 4 * MiB;
constexpr size_t WS_WIN = 8 * MiB;
constexpr size_t WS_WCAT = 208 * MiB, WS_WOUT = 272 * MiB;
constexpr size_t WS_H = 304 * MiB;
constexpr size_t WS_U = 432 * MiB, WS_G = 560 * MiB;
constexpr size_t WS_Q = 688 * MiB;
constexpr size_t WS_K = 816 * MiB, WS_V = 832 * MiB;
constexpr size_t WS_GA = 848 * MiB, WS_MR = 976 * MiB, WS_MA = 1104 * MiB;
constexpr size_t WS_LA = WS_WIN, WS_BB = WS_H;
#ifndef UC_PAD
#define UC_PAD 0
#endif
constexpr int UCP = DM + UC_PAD;
constexpr size_t WS_UC = WS_WIN;
constexpr size_t WS_MRG = WS_H;
constexpr size_t WS_Y2 = 1232 * MiB;
constexpr size_t WS_GO = 432 * MiB;
#ifndef F8Q
#define F8Q 1
#endif
#ifndef I8Q
#define I8Q 1
#endif
constexpr int CW_RS = 131072, CW_CS = 147456, CW_BIAS = 180224;
#ifndef I8A
#define I8A 1
#endif
constexpr int CW_RS2 = 212992, CW_CS2 = 229376;
constexpr float WQ8_SCALE = 64.0f;
constexpr size_t WS_H8 = WS_Y2;
#ifndef F8_SEGS
#define F8_SEGS ((1u << 1) | (1u << 2) | (1u << 3) | (1u << 4) | (1u << 6))
#endif
#ifndef F8_NG
#define F8_NG 0
#endif
#ifndef F8_NU
#define F8_NU 16
#endif
#ifndef F8_NMR
#define F8_NMR 16
#endif
#ifndef F8_MASK
#define F8_MASK ((F8_NG ? ((unsigned)F8_NG << 18) : 0u) | F8_SEGS | (F8_NMR ? ((1u << 5) | ((unsigned)F8_NMR << 8)) : 0u) | (F8_NU ? (1u | ((unsigned)F8_NU << 13)) : 0u))
#endif
constexpr bool ALL_LOWP = (F8Q == 1) && (I8Q != 0) && pg8::f8_count(F8_MASK) == 100;
constexpr size_t WS_WQ8 = WS_Y2 + 128 * MiB;
constexpr size_t WS_END = WS_WQ8 + 200 * MiB;
constexpr int CW_TMO = 0, CW_CODE = 1;
constexpr int CW_BAR = 4096;
constexpr int CW_MOD = 65536;

constexpr int RING_OFF = 0, RING_BYTES = 131072;
constexpr int LDSCTL_OFF = RING_BYTES, MISC_OFF = LDSCTL_OFF + 320;
constexpr int LDS_BYTES = 147456;

#define GAS __attribute__((address_space(1)))
#define LAS __attribute__((address_space(3)))
typedef unsigned short bf16;
typedef unsigned v4u __attribute__((ext_vector_type(4)));
typedef float f32x4 __attribute__((ext_vector_type(4)));
typedef short bf16x8 __attribute__((ext_vector_type(8)));
typedef GAS unsigned gu32;
typedef GAS unsigned long long gu64;
#define RLX_AGENT __ATOMIC_RELAXED, __HIP_MEMORY_SCOPE_AGENT
#define LDS_WAIT() asm volatile("s_waitcnt lgkmcnt(0)" ::: "memory")
#define VM_WAIT() asm volatile("s_waitcnt vmcnt(0)" ::: "memory")
__device__ __forceinline__ unsigned long long rt() { return __builtin_amdgcn_s_memrealtime(); }
__device__ __forceinline__ unsigned f2bf(float f) { unsigned u = __builtin_bit_cast(unsigned, f); return (u + 0x7fffu + ((u >> 16) & 1u)) >> 16; }
__device__ __forceinline__ unsigned pk2(float lo, float hi) { return f2bf(lo) | (f2bf(hi) << 16); }

#define XB_TMO      128
#define XB_XCNT(j)  (256  + 64 * (j))
#define XB_XSUB(j)  (1280 + 64 * (j))
#define XB_XGEN(j)  (2304 + 64 * (j))
#define XB_TOP      3328
#define XB_TOPGEN   3392
#define XCD_BAR_WORDS 3456
#define XB_SPIN_CAP (1u << 18)

__device__ __forceinline__ unsigned xb_ld(unsigned* p)              { return __hip_atomic_load(p, __ATOMIC_RELAXED, __HIP_MEMORY_SCOPE_AGENT); }
__device__ __forceinline__ unsigned xb_add(unsigned* p, unsigned v) { return __hip_atomic_fetch_add(p, v, __ATOMIC_RELAXED, __HIP_MEMORY_SCOPE_AGENT); }
__device__ __forceinline__ unsigned xb_xcc_id() { return (unsigned)__builtin_amdgcn_s_getreg((3 << 11) | 20) & 0xFu; }
#define XB_SPIN(cond, bar) do { unsigned _sp = 0; while (cond) { __builtin_amdgcn_s_sleep(1); \
    if ((++_sp & 255u) == 0u) { if (xb_ld(&(bar)[XB_TMO])) break; if (_sp > XB_SPIN_CAP) { atomicAdd(&(bar)[XB_TMO], 1u); break; } } } } while (0)

struct XcdBarrier {
    unsigned* bar; unsigned x;
    volatile LAS unsigned* st;
};

__device__ __forceinline__ XcdBarrier xcd_barrier_post(unsigned* bar, volatile LAS unsigned* st) {
    XcdBarrier b; b.bar = bar; b.x = xb_xcc_id(); b.st = st;
    if (threadIdx.x == 0) (void)xb_add(&bar[XB_XCNT(b.x)], 1u);
    return b;
}
__device__ __forceinline__ void xcd_barrier_complete(unsigned* bar, unsigned x, unsigned& nloc, unsigned& nx) {
    const unsigned G = gridDim.x * gridDim.y * gridDim.z;
    unsigned sum, cnt, mine, sp = 0u;
    for (;;) {
        sum = 0u; cnt = 0u; mine = 0u;
#pragma unroll
        for (unsigned j = 0; j < 16; ++j) { const unsigned c = xb_ld(&bar[XB_XCNT(j)]); sum += c; cnt += (c > 0u) ? 1u : 0u; mine = (j == x) ? c : mine; }
        if (sum == G) break;
        __builtin_amdgcn_s_sleep(1);
        if ((++sp & 255u) == 0u) { if (xb_ld(&bar[XB_TMO])) break; if (sp > XB_SPIN_CAP) { atomicAdd(&bar[XB_TMO], 1u); break; } }
    }
    nloc = mine > 0u ? mine : 1u; nx = cnt > 0u ? cnt : 1u;
}

__device__ __forceinline__ void xcd_barrier(const XcdBarrier& b) {
    asm volatile("s_waitcnt vmcnt(0)" ::: "memory");
    __syncthreads();
    if (threadIdx.x == 0) {
        unsigned* bar = b.bar;
        __builtin_amdgcn_s_waitcnt(0);
        unsigned nloc = b.st[0], nx = b.st[1];
        if (nloc == 0u) { xcd_barrier_complete(bar, b.x, nloc, nx); b.st[0] = nloc; b.st[1] = nx; }
        const unsigned old = xb_add(&bar[XB_XSUB(b.x)], 1u);
        const unsigned gen = old / nloc;
        if (old + 1u == (gen + 1u) * nloc) {
            __builtin_amdgcn_fence(__ATOMIC_RELEASE, "agent");
            asm volatile("s_waitcnt vmcnt(0)" ::: "memory");
            const unsigned og = xb_add(&bar[XB_TOP], 1u);
            const unsigned tg = og / nx;
            if (og + 1u == (tg + 1u) * nx) xb_add(&bar[XB_TOPGEN], 1u);
            else XB_SPIN(xb_ld(&bar[XB_TOPGEN]) == tg, bar);
            __builtin_amdgcn_fence(__ATOMIC_ACQUIRE, "agent");
            xb_add(&bar[XB_XGEN(b.x)], 1u);
            asm volatile("s_waitcnt vmcnt(0)" ::: "memory");
        } else {
            XB_SPIN(xb_ld(&bar[XB_XGEN(b.x)]) == gen, bar);
            __builtin_amdgcn_fence(__ATOMIC_ACQUIRE, "agent");
            asm volatile("s_waitcnt vmcnt(0)" ::: "memory");
        }
    }
    __syncthreads();
}

typedef unsigned v2u __attribute__((ext_vector_type(2)));
typedef float f32x16 __attribute__((ext_vector_type(16)));
typedef short s16x4 __attribute__((ext_vector_type(4)));
struct Args { const float* in[18]; float* out; unsigned char* ws; int ph_lo, ph_hi; };
struct Frame {
    LAS unsigned char* lds;
    volatile LAS unsigned* MISC;
    gu32* ctl;
    int tid, lane, wave, vcu, G;
};
__device__ __forceinline__ float wave_sum(float v) {
#pragma unroll
    for (int o = 1; o < 64; o <<= 1) v += __shfl_xor(v, o);
    return v;
}
__device__ __forceinline__ float wave_max(float v) {
#pragma unroll
    for (int o = 1; o < 64; o <<= 1) v = fmaxf(v, __shfl_xor(v, o));
    return v;
}
__device__ __forceinline__ unsigned pk4_i8(float a, float b, float c, float d) {
    const float M = 12582912.0f;
    const unsigned ua = __builtin_bit_cast(unsigned, a + M), ub = __builtin_bit_cast(unsigned, b + M), uc = __builtin_bit_cast(unsigned, c + M), ud = __builtin_bit_cast(unsigned, d + M);
    return __builtin_amdgcn_perm(ub, ua, 0x0c0c0400u) | __builtin_amdgcn_perm(ud, uc, 0x04000c0cu);
}
using pg8::cvtpk; using pg8::bflo; using pg8::bfhi; using pg8::sigmoid_f;

__device__ __forceinline__ unsigned pk4_fp8(float a, float b, float c, float d) { unsigned w = 0u; w = __builtin_amdgcn_cvt_pk_fp8_f32(a, b, w, false); w = __builtin_amdgcn_cvt_pk_fp8_f32(c, d, w, true); return w; }
__device__ __forceinline__ void p0_transpose_item(const float* W, int K, int N, bf16* WT, LAS float* scr, int item, int lane, int ldo = 0, unsigned char* WT8 = nullptr, unsigned f8mask = 0u, float f8scale = 1.0f) {
    const int nblk = N / 32, kb = item / nblk, nb = item % nblk, k0 = 64 * kb, n0 = 32 * nb;
    float wv[32];
#pragma unroll
    for (int i = 0; i < 32; ++i) wv[i] = __builtin_nontemporal_load(&W[(size_t)(k0 + 2 * i + (lane >> 5)) * N + n0 + (lane & 31)]);
#pragma unroll
    for (int i = 0; i < 32; ++i) scr[(2 * i + (lane >> 5)) * 33 + (lane & 31)] = wv[i];
    LDS_WAIT(); asm volatile("" ::: "memory");
    const int c = lane & 7;
    const int sl8 = WT8 != nullptr ? pg8::f8_slot(n0 >> 8, f8mask) : -1;
    if (sl8 >= 0) {
        const int r8 = sl8 * 256 + (n0 & 255);
#pragma unroll
        for (int j = 0; j < 4; ++j) { const int n = (lane >> 3) + 8 * j; const LAS float* s = scr + (8 * c) * 33 + n;
            v2u o; o.x = pk4_fp8(s[0 * 33] * f8scale, s[1 * 33] * f8scale, s[2 * 33] * f8scale, s[3 * 33] * f8scale); o.y = pk4_fp8(s[4 * 33] * f8scale, s[5 * 33] * f8scale, s[6 * 33] * f8scale, s[7 * 33] * f8scale);
            *(GAS v2u*)(WT8 + (size_t)(r8 + n) * (2 * K) + k0 + 8 * c) = o; }
    } else {
#pragma unroll
    for (int j = 0; j < 4; ++j) { const int n = (lane >> 3) + 8 * j; const LAS float* s = scr + (8 * c) * 33 + n;
        v4u o; o.x = cvtpk(s[0 * 33], s[1 * 33]); o.y = cvtpk(s[2 * 33], s[3 * 33]); o.z = cvtpk(s[4 * 33], s[5 * 33]); o.w = cvtpk(s[6 * 33], s[7 * 33]);
        *(GAS v4u*)(WT + (size_t)(n0 + n) * (ldo ? ldo : K) + k0 + 8 * c) = o; }
    }
    LDS_WAIT(); asm volatile("" ::: "memory");
}
__device__ __forceinline__ void p0_prologue(Frame& F, const Args& a, const bool with_mod) {
    LAS float* scr = (LAS float*)(F.lds + RING_OFF + F.wave * 16384);
    const int gw = F.vcu * NWAVES + F.wave, NGW = F.G * NWAVES, lane = F.lane;
    constexpr int I_IN = (DM / 64) * (DIN / 32), I_SQ = (DM / 64) * (DM / 32), I_GT = NCB * (CBW / 64) * (CBW / 32);
    constexpr int NITEMS = I_IN + 3 * I_SQ + 2 * I_GT;
    bf16* ws16 = (bf16*)a.ws;
    for (int it = gw; it < NITEMS; it += NGW) {
        int r = it;
        if (r < I_IN) { p0_transpose_item(a.in[5], DM, DIN, (bf16*)(a.ws + WS_WIN), scr, r, lane, 0, (F8Q == 1 && !I8Q) ? (unsigned char*)(a.ws + WS_WQ8) : nullptr, F8_MASK, WQ8_SCALE); continue; } r -= I_IN;
        if (r < I_SQ) { p0_transpose_item(a.in[14], DM, DM, (bf16*)(a.ws + WS_WCAT), scr, r, lane, 2 * DM); continue; } r -= I_SQ;
        if (r < I_SQ) { p0_transpose_item(a.in[15], DM, DM, (bf16*)(a.ws + WS_WCAT) + DM, scr, r, lane, 2 * DM); continue; } r -= I_SQ;
        if (r < I_SQ) { p0_transpose_item(a.in[16], DM, DM, (bf16*)(a.ws + WS_WOUT), scr, r, lane); continue; } r -= I_SQ;
        if (r < I_GT) { const int cbi = r >> 5; p0_transpose_item(a.in[8] + (size_t)cbi * 65536, CBW, CBW, (bf16*)(a.ws + WS_WGA) + (size_t)cbi * 65536, scr, r & 31, lane); continue; } r -= I_GT;
        { const int cbi = r >> 5; p0_transpose_item(a.in[10] + (size_t)cbi * 65536, CBW, CBW, (bf16*)(a.ws + WS_WGX) + (size_t)cbi * 65536, scr, r & 31, lane); }
    }
    (void)ws16;
    float* mod = (float*)(F.ctl + CW_MOD);
    if (with_mod) for (int task = gw; task < 48 * 32; task += NGW) {
        const int ec = task % 48, ds = task / 48;
        const float c0 = a.in[1][128 * ds + lane], c1 = a.in[1][128 * ds + 64 + lane];
        const float s0 = c0 / (1.0f + __expf(-c0)), s1 = c1 / (1.0f + __expf(-c1));
        f32x4 acc = {0.f, 0.f, 0.f, 0.f};
        const GAS f32x4* wp = (const GAS f32x4*)(a.in[2] + (size_t)(128 * ds) * 12288 + 256 * ec) + lane;
#pragma unroll 8
        for (int i = 0; i < 64; ++i) { const float s = __builtin_bit_cast(float, __builtin_amdgcn_readlane(__builtin_bit_cast(int, s0), i)); acc += wp[(size_t)i * 3072] * s; }
#pragma unroll 8
        for (int i = 0; i < 64; ++i) { const float s = __builtin_bit_cast(float, __builtin_amdgcn_readlane(__builtin_bit_cast(int, s1), i)); acc += wp[(size_t)(64 + i) * 3072] * s; }
        if (ds == 0) acc += *((const GAS f32x4*)(a.in[3] + 256 * ec) + lane);
        float* mp = mod + 256 * ec + 4 * lane;
        atomicAdd(mp + 0, acc[0]); atomicAdd(mp + 1, acc[1]); atomicAdd(mp + 2, acc[2]); atomicAdd(mp + 3, acc[3]);
    }
}

__device__ __forceinline__ void quant_row4096_load(v4u (&raw)[8], const unsigned char* p, int lane) {
    const GAS v4u* r = (const GAS v4u*)p + lane;
#pragma unroll
    for (int j = 0; j < 8; ++j) raw[j] = r[64 * j];
}
__device__ __forceinline__ float quant_row4096_finish(const v4u (&raw)[8], unsigned char* p, int lane) {
    float mx = 0.f;
#pragma unroll
    for (int j = 0; j < 8; ++j) { mx = fmaxf(mx, fmaxf(fmaxf(fabsf(bflo(raw[j].x)), fabsf(bfhi(raw[j].x))), fmaxf(fabsf(bflo(raw[j].y)), fabsf(bfhi(raw[j].y)))));
        mx = fmaxf(mx, fmaxf(fmaxf(fabsf(bflo(raw[j].z)), fabsf(bfhi(raw[j].z))), fmaxf(fabsf(bflo(raw[j].w)), fabsf(bfhi(raw[j].w))))); }
    mx = fmaxf(wave_max(mx), 1e-30f);
    const float q = 127.0f / mx;
    GAS v2u* o = (GAS v2u*)p + lane;
#pragma unroll
    for (int j = 0; j < 8; ++j) { v2u w; w.x = pk4_i8(bflo(raw[j].x) * q, bfhi(raw[j].x) * q, bflo(raw[j].y) * q, bfhi(raw[j].y) * q); w.y = pk4_i8(bflo(raw[j].z) * q, bfhi(raw[j].z) * q, bflo(raw[j].w) * q, bfhi(raw[j].w) * q); o[64 * j] = w; }
    return mx * (1.0f / 127.0f);
}
__device__ __forceinline__ float quant_row4096_inplace(unsigned char* p, int lane) { v4u raw[8]; quant_row4096_load(raw, p, lane); return quant_row4096_finish(raw, p, lane); }
__device__ __forceinline__ void p1_wrow(Frame& F, const Args& a, LAS float* GS, LAS float* SH, const v4u (&raw)[8], int c) {
    asm volatile("" ::: "memory");
    const int pn = pg8::f8_tile(c >> 8, F8_MASK), n = pn * 256 + (c & 255);
    float wp[8][8]; float mx = 0.f, bs = 0.f;
#pragma unroll
    for (int j = 0; j < 8; ++j) { const int k0 = 8 * F.lane + 512 * j; const f32x4 g0 = *(const LAS f32x4*)(GS + k0), g1 = *(const LAS f32x4*)(GS + k0 + 4), s0 = *(const LAS f32x4*)(SH + k0), s1 = *(const LAS f32x4*)(SH + k0 + 4);
        const float w0 = bflo(raw[j].x), w1 = bfhi(raw[j].x), w2 = bflo(raw[j].y), w3 = bfhi(raw[j].y), w4 = bflo(raw[j].z), w5 = bfhi(raw[j].z), w6 = bflo(raw[j].w), w7 = bfhi(raw[j].w);
        bs += (w0 * s0.x + w1 * s0.y) + (w2 * s0.z + w3 * s0.w) + (w4 * s1.x + w5 * s1.y) + (w6 * s1.z + w7 * s1.w);
        wp[j][0] = w0 * g0.x; wp[j][1] = w1 * g0.y; wp[j][2] = w2 * g0.z; wp[j][3] = w3 * g0.w; wp[j][4] = w4 * g1.x; wp[j][5] = w5 * g1.y; wp[j][6] = w6 * g1.z; wp[j][7] = w7 * g1.w;
#pragma unroll
        for (int e = 0; e < 8; ++e) mx = fmaxf(mx, fabsf(wp[j][e])); }
    mx = fmaxf(wave_max(mx), 1e-30f); bs = wave_sum(bs);
    const float qw = 127.0f / mx;
    GAS v2u* o = (GAS v2u*)((unsigned char*)(a.ws + WS_WQ8) + (size_t)c * (2 * DM)) + F.lane;
#pragma unroll
    for (int j = 0; j < 8; ++j) { v2u w; w.x = pk4_i8(wp[j][0] * qw, wp[j][1] * qw, wp[j][2] * qw, wp[j][3] * qw); w.y = pk4_i8(wp[j][4] * qw, wp[j][5] * qw, wp[j][6] * qw, wp[j][7] * qw); o[64 * j] = w; }
    if (F.lane == 0) { ((GAS float*)(F.ctl + CW_CS))[n] = mx * (1.0f / 127.0f); ((GAS float*)(F.ctl + CW_BIAS))[n] = bs; }
}

__device__ __forceinline__ void p1_hrows(Frame& F, const Args& a) {
    LAS float* GS = (LAS float*)(F.lds + RING_OFF); LAS float* SH = GS + DM;
    const GAS float* mod = (const GAS float*)(F.ctl + CW_MOD);
#if defined(MOD_NAIVE)
    { float* modw = (float*)(F.ctl + CW_MOD) + 3 * DM + 64;
      for (int e = F.tid; e < 3 * DM; e += NWAVES * 64) { double s = 0.0; for (int d = 0; d < DM; ++d) { const double cv = (double)a.in[1][d]; s += cv / (1.0 + exp(-cv)) * (double)a.in[2][(size_t)d * (3 * DM) + e]; } modw[e] = (float)(s + (double)a.in[3][e]); }
      __syncthreads(); mod = (const GAS float*)modw; }
#endif
    LAS float* SA = SH + DM; LAS float* SB = SA + DM;
    for (int d = F.tid; d < DM; d += NWAVES * 64) { const float sg = a.in[4][d] * (1.0f + mod[DM + d]); GS[d] = sg; SH[d] = mod[d]; const float sa = sqrtf(fabsf(sg)); SA[d] = sa; SB[d] = sa > 0.f ? sg / sa : 0.f; }
    __syncthreads();
    const int gw = F.vcu * NWAVES + F.wave, NGW = F.G * NWAVES;
    bf16* H = (bf16*)(a.ws + WS_H);
#pragma unroll 1
    for (int m = gw; m < SEQ; m += NGW) {
        asm volatile("" ::: "memory");
        const GAS f32x4* xr = (const GAS f32x4*)(a.in[0] + (size_t)m * DM) + F.lane;
        f32x4 v[16]; float s = 0.f;
#pragma unroll
        for (int j = 0; j < 16; ++j) { v[j] = __builtin_nontemporal_load(xr + 64 * j); s += (v[j].x * v[j].x + v[j].y * v[j].y) + (v[j].z * v[j].z + v[j].w * v[j].w); }
        const float rstd = 1.0f / sqrtf(wave_sum(s) * (1.0f / DM) + EPS);
        GAS v2u* o8 = (GAS v2u*)(H + (size_t)m * DM) + F.lane;
        float qk = 0.f;
        if (F8Q && I8Q) {
            float mx = 0.f;
#pragma unroll
            for (int j = 0; j < 16; ++j) { const f32x4 t = v[j] * *(const LAS f32x4*)(SA + 4 * F.lane + 256 * j); mx = fmaxf(mx, fmaxf(fmaxf(fabsf(t.x), fabsf(t.y)), fmaxf(fabsf(t.z), fabsf(t.w)))); if (ALL_LOWP) v[j] = t; }
            mx = fmaxf(wave_max(mx), 1e-30f);
            qk = 127.0f / mx;
            if (F.lane == 0) ((GAS float*)(F.ctl + CW_RS))[m] = mx * rstd * (1.0f / 127.0f);
        }
#pragma unroll
        for (int j = 0; j < 16; ++j) { const int col = 4 * F.lane + 256 * j;
            if (ALL_LOWP) { *(GAS unsigned*)((unsigned char*)(a.ws + WS_H8) + (size_t)m * (2 * DM) + col) = pk4_i8(v[j].x * qk, v[j].y * qk, v[j].z * qk, v[j].w * qk); continue; }
            const f32x4 g = *(const LAS f32x4*)(GS + col), sh = *(const LAS f32x4*)(SH + col);
            const f32x4 o = v[j] * rstd * g + sh; v2u w; w.x = cvtpk(o.x, o.y); w.y = cvtpk(o.z, o.w); o8[64 * j] = w;
            if (F8Q && I8Q) { const f32x4 t = v[j] * *(const LAS f32x4*)(SA + col); *(GAS unsigned*)((unsigned char*)(a.ws + WS_H8) + (size_t)m * (2 * DM) + col) = pk4_i8(t.x * qk, t.y * qk, t.z * qk, t.w * qk); }
            else if (F8Q) *(GAS unsigned*)((unsigned char*)(a.ws + WS_H8) + (size_t)m * (2 * DM) + col) = pk4_fp8(o.x, o.y, o.z, o.w); }
    }
    if (F8Q && I8Q) {
        const int ncol = pg8::f8_count(F8_MASK) * 256;
        const bf16* WT = (const bf16*)(a.ws + WS_WIN);
        v4u rawA[8], rawB[8];
#define P1_WLOAD(raw, c_) do { const int pn_ = pg8::f8_tile((c_) >> 8, F8_MASK), n_ = pn_ * 256 + ((c_) & 255); const GAS v4u* wr_ = (const GAS v4u*)(WT + (size_t)n_ * DM) + F.lane; \
            _Pragma("unroll") for (int j = 0; j < 8; ++j) raw[j] = wr_[64 * j]; } while (0)
        int c = gw;
        if (c < ncol) P1_WLOAD(rawA, c);
#pragma unroll 1
        while (c < ncol) {
            const int c1 = c + NGW, c2 = c1 + NGW;
            if (c1 < ncol) P1_WLOAD(rawB, c1);
            __builtin_amdgcn_sched_barrier(0);
            p1_wrow(F, a, SB, SH, rawA, c);
            if (c1 >= ncol) break;
            if (c2 < ncol) P1_WLOAD(rawA, c2);
            __builtin_amdgcn_sched_barrier(0);
            p1_wrow(F, a, SB, SH, rawB, c1);
            c = c2;
        }
#undef P1_WLOAD
    }
    if (I8A) {
#pragma unroll 1
        for (int n = gw; n < DM; n += NGW) { asm volatile("" ::: "memory");
            const float sc = quant_row4096_inplace((unsigned char*)(a.ws + WS_WCAT) + (size_t)n * (4 * DM) + 2 * DM, F.lane);
            if (F.lane == 0) ((GAS float*)(F.ctl + CW_CS2))[n] = sc; }
    }
}
__device__ __forceinline__ void p4q_rows(Frame& F, const Args& a) {
    const int gw = F.vcu * NWAVES + F.wave, NGW = F.G * NWAVES;
    unsigned char* base = (unsigned char*)(a.ws + WS_Y2) + 2 * DM;
    GAS float* RSo = (GAS float*)(F.ctl + CW_RS2);
    v4u rawA[8], rawB[8];
    int m = gw;
    if (m < SEQ) quant_row4096_load(rawA, base + (size_t)m * (4 * DM), F.lane);
#pragma unroll 1
    while (m < SEQ) {
        const int m1 = m + NGW, m2 = m1 + NGW;
        if (m1 < SEQ) quant_row4096_load(rawB, base + (size_t)m1 * (4 * DM), F.lane);
        __builtin_amdgcn_sched_barrier(0);
        { const float sc = quant_row4096_finish(rawA, base + (size_t)m * (4 * DM), F.lane); if (F.lane == 0) RSo[m] = sc; }
        if (m1 >= SEQ) break;
        if (m2 < SEQ) quant_row4096_load(rawA, base + (size_t)m2 * (4 * DM), F.lane);
        __builtin_amdgcn_sched_barrier(0);
        { const float sc = quant_row4096_finish(rawB, base + (size_t)m1 * (4 * DM), F.lane); if (F.lane == 0) RSo[m1] = sc; }
        m = m2;
    }
}

constexpr int APITCH = 528, ATILE = 64 * APITCH;
template <int PASS, int VAR = 0>
__device__ __forceinline__ void scan_pass(Frame& F, const Args& a, float* AGG) {
    LAS unsigned char* AT0 = F.lds + RING_OFF;
    LAS float* CW = (LAS float*)(F.lds + RING_OFF + 2 * ATILE);
    const int tid = F.tid, lane = F.lane, w = F.wave, q = lane >> 4, j = lane & 15;
    const bf16* U = (const bf16*)(a.ws + WS_U); const bf16* Gr = (const bf16*)(a.ws + WS_G); bf16* Y = (bf16*)(a.ws + WS_Y2);
    bf16* LA = (bf16*)(a.ws + WS_LA); bf16* BB = (bf16*)(a.ws + WS_BB);
    const int tg = tid >> 5, cg = tid & 31;
    for (int vb = blockIdx.x; vb < 256; vb += gridDim.x) {
        const int seg = vb & 7, half = (vb >> 3) & 1, cb = vb >> 4;
        __syncthreads();
        for (int i = tid; i < 5 * 256; i += NWAVES * 64) { const int k = i >> 8, c = i & 255; CW[i] = (k < 4) ? a.in[6][k * DM + cb * CBW + c] : a.in[7][cb * CBW + c]; }
        const int chl = half * 128 + 16 * w + j, ch = cb * CBW + chl;
        bf16x8 wa[8], wx[8];
        { const GAS bf16x8* pa = (const GAS bf16x8*)((const bf16*)(a.ws + WS_WGA) + (size_t)ch * CBW + 8 * q); const GAS bf16x8* px = (const GAS bf16x8*)((const bf16*)(a.ws + WS_WGX) + (size_t)ch * CBW + 8 * q);
#pragma unroll
          for (int kk = 0; kk < 8; ++kk) { wa[kk] = pa[4 * kk]; wx[kk] = px[4 * kk]; } }
        const float ba = a.in[9][ch], bx = a.in[11][ch];
        const float cl = -8.0f * log1pf(expf(-a.in[12][ch]));
        float c = 0.f, Ac = 1.f;
        if (PASS == 2) for (int s = 0; s < 8 * seg; ++s) { const float2 ah = *(const float2*)(AGG + ((size_t)s * DM + ch) * 2); c = ah.x * c + ah.y; }
        const int NST = (PASS == 1) ? 28 : 32;
        const int t0 = (PASS == 1) ? seg * 1792 : seg * 2048;
        const bf16* ucol = U + cb * CBW + 8 * cg;
        v4u R[7];
#define SCAN_LOAD(tb) do { _Pragma("unroll") for (int rr = 0; rr < 7; ++rr) { const int t = (tb) + 4 * tg - 3 + rr; if (VAR & 1) R[rr] = (v4u){(unsigned)t, 0x3f803f80u, (unsigned)rr, 0x3f003f00u}; else R[rr] = (t >= 0) ? *(const GAS v4u*)(ucol + (size_t)t * DM) : (v4u){0u, 0u, 0u, 0u}; } } while (0)
#define SCAN_CONV(buf) do { \
            f32x4 wk[4][2]; _Pragma("unroll") for (int k = 0; k < 4; ++k) { wk[k][0] = *(const LAS f32x4*)(CW + k * 256 + 8 * cg); wk[k][1] = *(const LAS f32x4*)(CW + k * 256 + 8 * cg + 4); } \
            const f32x4 cb0 = *(const LAS f32x4*)(CW + 1024 + 8 * cg), cb1 = *(const LAS f32x4*)(CW + 1024 + 8 * cg + 4); \
            _Pragma("unroll") for (int tt = 0; tt < 4; ++tt) { f32x4 o0 = cb0, o1 = cb1; \
                if (VAR & 2) { *(LAS v4u*)(AT0 + (buf) * ATILE + (4 * tg + tt) * APITCH + cg * 16) = R[tt + 3]; continue; } \
                _Pragma("unroll") for (int k = 0; k < 4; ++k) { const v4u x = R[tt + k]; \
                    o0 += wk[k][0] * (f32x4){bflo(x.x), bfhi(x.x), bflo(x.y), bfhi(x.y)}; o1 += wk[k][1] * (f32x4){bflo(x.z), bfhi(x.z), bflo(x.w), bfhi(x.w)}; } \
                v4u ow; ow.x = cvtpk(o0[0], o0[1]); ow.y = cvtpk(o0[2], o0[3]); ow.z = cvtpk(o1[0], o1[1]); ow.w = cvtpk(o1[2], o1[3]); \
                *(LAS v4u*)(AT0 + (buf) * ATILE + (4 * tg + tt) * APITCH + cg * 16) = ow; } } while (0)
        __syncthreads();
        SCAN_LOAD(t0); SCAN_CONV(0);
        __syncthreads();
        for (int st = 0; st < NST; ++st) {
            if (st + 1 < NST) SCAN_LOAD(t0 + 64 * (st + 1));
            const LAS unsigned char* At = AT0 + (st & 1) * ATILE;
#pragma unroll
            for (int wt = 0; wt < 4; ++wt) {
                const int trow = 16 * wt, tglob = t0 + 64 * st + trow + 4 * q;
                unsigned short gbits[4];
                if (PASS == 2) {
#pragma unroll
                    for (int v = 0; v < 4; ++v) gbits[v] = *(const GAS unsigned short*)(Gr + (size_t)(tglob + v) * DM + ch); }
                f32x4 accA = {0.f, 0.f, 0.f, 0.f}, accX = {0.f, 0.f, 0.f, 0.f};
#pragma unroll
                for (int kk = 0; kk < 8; ++kk) { if ((VAR & 32) && kk > 0) continue; const bf16x8 af = *(const LAS bf16x8*)(At + (trow + j) * APITCH + kk * 64 + q * 16);
                    if (VAR & 4) { accA[kk & 3] += __builtin_bit_cast(float, (int)af[0] << 16); accX[kk & 3] += __builtin_bit_cast(float, (int)af[5] << 16); }
                    else { accA = __builtin_amdgcn_mfma_f32_16x16x32_bf16(af, wa[kk], accA, 0, 0, 0); accX = __builtin_amdgcn_mfma_f32_16x16x32_bf16(af, wx[kk], accX, 0, 0, 0); } }
                float av[4], bv[4];
#pragma unroll
                for (int v = 0; v < 4; ++v) {
                    const float uval = __builtin_bit_cast(float, (unsigned)(*(const LAS unsigned short*)(At + (trow + 4 * q + v) * APITCH + chl * 2)) << 16);
                    if (VAR & 8) { av[v] = accA[v] * 0.25f + ba; bv[v] = accX[v] * uval + bx; continue; }
                    const float r = sigmoid_f(accA[v] + ba), ii = sigmoid_f(accX[v] + bx);
                    const float la2 = cl * r * LOG2E;
                    const float aa = __builtin_amdgcn_exp2f(la2);
                    const float om = __builtin_fmaf(-aa, aa, 1.0f);
                    av[v] = aa; bv[v] = __builtin_amdgcn_sqrtf(om) * (ii * uval);
#if defined(SCAN_STORED)
                    if (PASS == 1) { const unsigned pk = cvtpk(la2, bv[v]); *(GAS unsigned short*)(LA + (size_t)(tglob + v) * DM + ch) = (unsigned short)(pk & 0xffffu); *(GAS unsigned short*)(BB + (size_t)(tglob + v) * DM + ch) = (unsigned short)(pk >> 16);
                        av[v] = __builtin_amdgcn_exp2f(bflo(pk)); bv[v] = bfhi(pk); }
#endif
                }
                float A = av[0], Hh = bv[0];
#pragma unroll
                for (int v = 1; v < 4; ++v) { Hh = av[v] * Hh + bv[v]; A = A * av[v]; }
                if (!(VAR & 16)) { const float A1 = __shfl_up(A, 16), H1 = __shfl_up(Hh, 16); if (q >= 1) { Hh = A * H1 + Hh; A = A * A1; } }
                if (!(VAR & 16)) { const float A2 = __shfl_up(A, 32), H2 = __shfl_up(Hh, 32); if (q >= 2) { Hh = A * H2 + Hh; A = A * A2; } }
                if (PASS == 2) {
                    float Aex = __shfl_up(A, 16), Hex = __shfl_up(Hh, 16); if (q == 0) { Aex = 1.0f; Hex = 0.0f; }
                    float h = Aex * c + Hex;
#pragma unroll
                    for (int v = 0; v < 4; ++v) { h = av[v] * h + bv[v];
                        const float g = __builtin_bit_cast(float, (unsigned)gbits[v] << 16);
                        *(GAS unsigned short*)(Y + (size_t)(tglob + v) * (2 * DM) + ch) = (unsigned short)(cvtpk(h * g, 0.f) & 0xffffu); }
                }
                const float At_ = (VAR & 16) ? A : __shfl(A, 48 + j), Ht_ = (VAR & 16) ? Hh : __shfl(Hh, 48 + j);
                c = At_ * c + Ht_; Ac = Ac * At_;
            }
            if (st + 1 < NST) SCAN_CONV((st + 1) & 1);
            if (PASS == 1 && (st & 3) == 3) { if (q == 0) *(float2*)(AGG + ((size_t)(seg * 7 + (st >> 2)) * DM + ch) * 2) = make_float2(Ac, c); c = 0.f; Ac = 1.f; }
            __syncthreads();
        }
#undef SCAN_LOAD
#undef SCAN_CONV
    }
}


template <int PASS, int NT>
__device__ __forceinline__ void scan_dma(Frame& F, const Args& a, float* AGG) {
    constexpr int NSEG = (NT == 1) ? 8 : 16, SEGLEN = SEQ / NSEG, NST = SEGLEN / 64;
    LAS unsigned char* AT0 = F.lds + RING_OFF;
    const int lane = F.lane, w = F.wave, q = lane >> 4, j = lane & 15;
    const bf16* UC = (const bf16*)(a.ws + WS_UC); const bf16* Gr = (const bf16*)(a.ws + WS_G); bf16* Y = (bf16*)(a.ws + WS_Y2);
    for (int vb = blockIdx.x; vb < 256; vb += gridDim.x) {
        const int seg = vb & (NSEG - 1), half = (NT == 1) ? ((vb >> 3) & 1) : 0, cb = vb >> 4;
        if (PASS == 1 && seg == NSEG - 1) continue;
        const int chl0 = (NT == 1) ? (half * 128 + 16 * w + j) : (32 * w + j), ch0 = cb * CBW + chl0;
        bf16x8 wa[NT][8], wx[NT][8]; float ba[NT], bx[NT], cl2[NT], c[NT], Ac[NT];
#pragma unroll
        for (int nt = 0; nt < NT; ++nt) { const int ch = ch0 + 16 * nt;
            const GAS bf16x8* pa = (const GAS bf16x8*)((const bf16*)(a.ws + WS_WGA) + (size_t)ch * CBW + 8 * q); const GAS bf16x8* px = (const GAS bf16x8*)((const bf16*)(a.ws + WS_WGX) + (size_t)ch * CBW + 8 * q);
#pragma unroll
            for (int kk = 0; kk < 8; ++kk) { wa[nt][kk] = pa[4 * kk]; wx[nt][kk] = px[4 * kk]; }
            ba[nt] = a.in[9][ch]; bx[nt] = a.in[11][ch]; cl2[nt] = -8.0f * log1pf(expf(-a.in[12][ch])) * LOG2E;
            c[nt] = 0.f; Ac[nt] = 1.f;
            if (PASS == 2) for (int s = 0; s < seg; ++s) { const float2 ah = *(const float2*)(AGG + ((size_t)s * DM + ch) * 2); c[nt] = ah.x * c[nt] + ah.y; } }
        const int t0 = seg * SEGLEN;
        const bf16* dsrc[4];
#pragma unroll
        for (int d = 0; d < 4; ++d) { const int r64 = 8 * w + 2 * d + (lane >> 5); dsrc[d] = UC + (size_t)(t0 + r64) * UCP + cb * CBW + (((lane & 31) ^ (r64 & 15)) << 3); }
        const bf16* gsrc = Gr + (size_t)(t0 + 4 * q) * DM + ch0;
#define SD_ISSUE(st_, buf_) do { _Pragma("unroll") for (int d = 0; d < 4; ++d) \
            __builtin_amdgcn_global_load_lds((const unsigned*)(dsrc[d] + (size_t)(st_) * 64 * UCP), (LAS unsigned*)(AT0 + (buf_) * 32768 + (8 * w + 2 * d) * 512), 16, 0, 0); } while (0)
#define SD_GLOAD(st_, g_) do { if (PASS == 2) { _Pragma("unroll") for (int nt = 0; nt < NT; ++nt) _Pragma("unroll") for (int e = 0; e < 16; ++e) g_[nt][e] = *(const GAS unsigned short*)(gsrc + (size_t)((st_) * 64 + 16 * (e >> 2) + (e & 3)) * DM + 16 * nt); } } while (0)
#define SD_TILE(st_, gcur_, gnxt_) do { \
            if ((st_) + 1 < NST) { SD_ISSUE((st_) + 1, ((st_) + 1) & 1); if (NT == 1) SD_GLOAD((st_) + 1, gnxt_); } \
            asm volatile("" ::: "memory"); __builtin_amdgcn_sched_barrier(0); \
            const LAS unsigned char* At = AT0 + ((st_) & 1) * 32768; \
            _Pragma("unroll") for (int wt = 0; wt < 4; ++wt) { \
                if (NT == 2) __builtin_amdgcn_sched_barrier(0);     \
                const int trow = 16 * wt, tglob = t0 + 64 * (st_) + trow + 4 * q; \
                f32x4 accA[NT], accX[NT]; unsigned gw[NT][4];     \
                if (NT == 2 && PASS == 2) { _Pragma("unroll") for (int nt = 0; nt < NT; ++nt) _Pragma("unroll") for (int v = 0; v < 4; ++v) gw[nt][v] = *(const GAS unsigned short*)(gsrc + (size_t)((st_) * 64 + trow + v) * DM + 16 * nt); } \
                _Pragma("unroll") for (int nt = 0; nt < NT; ++nt) { accA[nt] = (f32x4){0.f, 0.f, 0.f, 0.f}; accX[nt] = (f32x4){0.f, 0.f, 0.f, 0.f}; } \
                _Pragma("unroll") for (int kk = 0; kk < 8; ++kk) { const bf16x8 af = *(const LAS bf16x8*)(At + (trow + j) * 512 + (((4 * kk + q) ^ j) << 4)); \
                    _Pragma("unroll") for (int nt = 0; nt < NT; ++nt) { accA[nt] = __builtin_amdgcn_mfma_f32_16x16x32_bf16(af, wa[nt][kk], accA[nt], 0, 0, 0); accX[nt] = __builtin_amdgcn_mfma_f32_16x16x32_bf16(af, wx[nt][kk], accX[nt], 0, 0, 0); } } \
                _Pragma("unroll") for (int nt = 0; nt < NT; ++nt) { \
                    const int chl = chl0 + 16 * nt; \
                    float av[4], bv[4]; \
                    _Pragma("unroll") for (int v = 0; v < 4; ++v) { \
                        const int rr = trow + 4 * q + v; \
                        const float uval = __builtin_bit_cast(float, (unsigned)(*(const LAS unsigned short*)(At + rr * 512 + ((((chl >> 3) ^ (rr & 15)) << 4) | ((chl & 7) << 1)))) << 16); \
                        const float r = sigmoid_f(accA[nt][v] + ba[nt]), ii = sigmoid_f(accX[nt][v] + bx[nt]); \
                        const float aa = __builtin_amdgcn_exp2f(cl2[nt] * r); \
                        const float om = __builtin_fmaf(-aa, aa, 1.0f); \
                        av[v] = aa; bv[v] = __builtin_amdgcn_sqrtf(om) * (ii * uval); } \
                    float A = av[0], Hh = bv[0]; \
                    _Pragma("unroll") for (int v = 1; v < 4; ++v) { Hh = av[v] * Hh + bv[v]; A = A * av[v]; } \
                    { const float A1 = __shfl_up(A, 16), H1 = __shfl_up(Hh, 16); if (q >= 1) { Hh = A * H1 + Hh; A = A * A1; } } \
                    { const float A2 = __shfl_up(A, 32), H2 = __shfl_up(Hh, 32); if (q >= 2) { Hh = A * H2 + Hh; A = A * A2; } } \
                    if (PASS == 2) { \
                        float Aex = __shfl_up(A, 16), Hex = __shfl_up(Hh, 16); if (q == 0) { Aex = 1.0f; Hex = 0.0f; } \
                        float h = Aex * c[nt] + Hex; \
                        _Pragma("unroll") for (int v = 0; v < 4; ++v) { h = av[v] * h + bv[v]; \
                            const float g = __builtin_bit_cast(float, ((NT == 2) ? gw[nt][v] : gcur_[nt][(NT == 2) ? 0 : (4 * wt + v)]) << 16); \
                            *(GAS unsigned short*)(Y + (size_t)(tglob + v) * (2 * DM) + ch0 + 16 * nt) = (unsigned short)(cvtpk(h * g, 0.f) & 0xffffu); } } \
                    const float At_ = __shfl(A, 48 + j), Ht_ = __shfl(Hh, 48 + j); \
                    c[nt] = At_ * c[nt] + Ht_; Ac[nt] = Ac[nt] * At_; } } \
              \
            if (PASS == 2) { if (NT == 1) asm volatile("s_waitcnt vmcnt(16) lgkmcnt(0)" ::: "memory"); else asm volatile("s_waitcnt vmcnt(8) lgkmcnt(0)" ::: "memory"); }     \
            else asm volatile("s_waitcnt vmcnt(0) lgkmcnt(0)" ::: "memory"); \
            __builtin_amdgcn_s_barrier(); asm volatile("" ::: "memory"); } while (0)
        unsigned gA[NT][(NT == 1) ? 16 : 1], gB[1][(NT == 1) ? 16 : 1];
        __syncthreads();
        SD_ISSUE(0, 0); if (NT == 1) SD_GLOAD(0, gA);
        asm volatile("s_waitcnt vmcnt(0)" ::: "memory"); __builtin_amdgcn_s_barrier(); asm volatile("" ::: "memory");
#pragma unroll 1
        for (int st = 0; st < NST; st += 2) { if (NT == 1) { SD_TILE(st, gA, gB); SD_TILE(st + 1, gB, gA); } else { SD_TILE(st, gA, gA); SD_TILE(st + 1, gA, gA); } }
        if (PASS == 1 && q == 0) {
#pragma unroll
            for (int nt = 0; nt < NT; ++nt) *(float2*)(AGG + ((size_t)seg * DM + ch0 + 16 * nt) * 2) = make_float2(Ac[nt], c[nt]); }
#undef SD_ISSUE
#undef SD_GLOAD
#undef SD_TILE
    }
}

__device__ __forceinline__ void scan_light(Frame& F, const Args& a) {
    const int lane = F.lane, w = F.wave, q = lane >> 4, j = lane & 15;
    const bf16* LA = (const bf16*)(a.ws + WS_LA); const bf16* BB = (const bf16*)(a.ws + WS_BB); const bf16* Gr = (const bf16*)(a.ws + WS_G); bf16* Y = (bf16*)(a.ws + WS_Y2);
    const float* AGG = (const float*)(a.ws + WS_AGG);
    for (int vb = blockIdx.x; vb < 256; vb += gridDim.x) {
        const int seg = vb & 7, half = (vb >> 3) & 1, cb = vb >> 4;
        const int ch = cb * CBW + half * 128 + 16 * w + j;
        float c = 0.f;
        for (int s = 0; s < seg; ++s) { const float2 ah = *(const float2*)(AGG + ((size_t)s * DM + ch) * 2); c = ah.x * c + ah.y; }
        const size_t base = (size_t)(seg * 2048 + 16 * q) * DM + ch;
        unsigned l0[16], b0[16], g0[16], l1[16], b1[16], g1[16];
#define SL_LOAD(tile, l_, b_, g_) do { _Pragma("unroll") for (int v = 0; v < 16; ++v) { const size_t o_ = base + (size_t)((tile) * 64 + v) * DM; \
            l_[v] = *(const GAS unsigned short*)(LA + o_); b_[v] = *(const GAS unsigned short*)(BB + o_); g_[v] = *(const GAS unsigned short*)(Gr + o_); } } while (0)
#define SL_TILE(tile, l_, b_, g_) do { \
            float av[16], A, Hh; \
            _Pragma("unroll") for (int v = 0; v < 16; ++v) av[v] = __builtin_amdgcn_exp2f(__builtin_bit_cast(float, l_[v] << 16)); \
            A = av[0]; Hh = __builtin_bit_cast(float, b_[0] << 16); \
            _Pragma("unroll") for (int v = 1; v < 16; ++v) { Hh = av[v] * Hh + __builtin_bit_cast(float, b_[v] << 16); A = A * av[v]; } \
            { const float A1 = __shfl_up(A, 16), H1 = __shfl_up(Hh, 16); if (q >= 1) { Hh = A * H1 + Hh; A = A * A1; } } \
            { const float A2 = __shfl_up(A, 32), H2 = __shfl_up(Hh, 32); if (q >= 2) { Hh = A * H2 + Hh; A = A * A2; } } \
            float Aex = __shfl_up(A, 16), Hex = __shfl_up(Hh, 16); if (q == 0) { Aex = 1.0f; Hex = 0.0f; } \
            float h = Aex * c + Hex; \
            _Pragma("unroll") for (int v = 0; v < 16; ++v) { h = av[v] * h + __builtin_bit_cast(float, b_[v] << 16); \
                *(GAS unsigned short*)(Y + ((size_t)(seg * 2048 + 16 * q + (tile) * 64 + v)) * (2 * DM) + ch) = (unsigned short)(cvtpk(h * __builtin_bit_cast(float, g_[v] << 16), 0.f) & 0xffffu); } \
            const float At_ = __shfl(A, 48 + j), Ht_ = __shfl(Hh, 48 + j); c = At_ * c + Ht_; } while (0)
        SL_LOAD(0, l0, b0, g0);
#pragma unroll 1
        for (int tile = 0; tile < 32; tile += 2) {
            SL_LOAD(tile + 1, l1, b1, g1);
            SL_TILE(tile, l0, b0, g0);
            if (tile + 2 < 32) SL_LOAD(tile + 2, l0, b0, g0);
            SL_TILE(tile + 1, l1, b1, g1);
        }
#undef SL_LOAD
#undef SL_TILE
    }
}

__device__ __forceinline__ void conv_pass(Frame& F, const Args& a) {
    const bf16* U = (const bf16*)(a.ws + WS_U); bf16* UC = (bf16*)(a.ws + WS_UC);
    const int gt = (int)blockIdx.x * (NWAVES * 64) + F.tid, cg = gt & 511, tstep = (F.G * NWAVES * 64) >> 9;
    f32x4 wk[4][2];
#pragma unroll
    for (int k = 0; k < 4; ++k) { wk[k][0] = *(const GAS f32x4*)(a.in[6] + k * DM + 8 * cg); wk[k][1] = *(const GAS f32x4*)(a.in[6] + k * DM + 8 * cg + 4); }
    const f32x4 cb0 = *(const GAS f32x4*)(a.in[7] + 8 * cg), cb1 = *(const GAS f32x4*)(a.in[7] + 8 * cg + 4);
#pragma unroll 1
    for (int tg = gt >> 9; tg < SEQ / 4; tg += tstep) {
        const int t = 4 * tg; v4u R[7];
#pragma unroll
        for (int rr = 0; rr < 7; ++rr) { const int tt = t - 3 + rr; R[rr] = (tt >= 0) ? *(const GAS v4u*)(U + (size_t)tt * DM + 8 * cg) : (v4u){0u, 0u, 0u, 0u}; }
#pragma unroll
        for (int tt = 0; tt < 4; ++tt) { f32x4 o0 = cb0, o1 = cb1;
#pragma unroll
            for (int k = 0; k < 4; ++k) { const v4u x = R[tt + k];
                o0 += wk[k][0] * (f32x4){bflo(x.x), bfhi(x.x), bflo(x.y), bfhi(x.y)}; o1 += wk[k][1] * (f32x4){bflo(x.z), bfhi(x.z), bflo(x.w), bfhi(x.w)}; }
            v4u ow; ow.x = cvtpk(o0[0], o0[1]); ow.y = cvtpk(o0[2], o0[3]); ow.z = cvtpk(o1[0], o1[1]); ow.w = cvtpk(o1[2], o1[3]);
            *(GAS v4u*)(UC + (size_t)(t + tt) * UCP + 8 * cg) = ow; }
    }
}

#ifndef AT16_VAR
#define AT16_VAR 0
#endif
__device__ __forceinline__ void scan_at16(Frame& F, const Args& a, bf16* Yout, const int ypitch) {
    typedef float f32x2v __attribute__((ext_vector_type(2)));
    LAS f32x2v* AGL = (LAS f32x2v*)(F.lds + RING_OFF);
    const int lane = F.lane, w = F.wave, q = lane >> 4, j = lane & 15;
    const bf16* UC = (const bf16*)(a.ws + WS_UC); const bf16* Gr = (const bf16*)(a.ws + WS_G); bf16* Y = Yout;
    for (int vb = blockIdx.x; vb < 256; vb += gridDim.x) {
        const int cb = (vb & 7) * 2 + (vb >> 7), c16 = (vb >> 3) & 15;
        const int chl = 16 * c16 + j, ch = cb * CBW + chl;
        bf16x8 wa[8], wx[8];
        { const GAS bf16x8* pa = (const GAS bf16x8*)((const bf16*)(a.ws + WS_WGA) + (size_t)ch * CBW + 8 * q); const GAS bf16x8* px = (const GAS bf16x8*)((const bf16*)(a.ws + WS_WGX) + (size_t)ch * CBW + 8 * q);
#pragma unroll
          for (int kk = 0; kk < 8; ++kk) { wa[kk] = pa[4 * kk]; wx[kk] = px[4 * kk]; } }
        const float ba = a.in[9][ch], bx = a.in[11][ch];
        const float cl2 = -8.0f * log1pf(expf(-a.in[12][ch])) * LOG2E;
        float C = 0.f;
        const bf16* arow = UC + (size_t)(16 * w + j) * UCP + cb * CBW + 8 * q;
        const bf16* grow = Gr + (size_t)(16 * w + 4 * q) * DM + ch; const bf16* urow = UC + (size_t)(16 * w + 4 * q) * UCP + ch;
        bf16x8 af0[8], af1[8]; unsigned g0[4], u0[4], g1[4], u1[4];
#define AT_LOAD(r_, af_, g_, u_) do { if (!(AT16_VAR & 32)) { _Pragma("unroll") for (int kk = 0; kk < 8; ++kk) af_[kk] = *(const GAS bf16x8*)(arow + (size_t)(r_) * 128 * UCP + 32 * kk); } \
            if (!(AT16_VAR & 16)) { _Pragma("unroll") for (int v = 0; v < 4; ++v) g_[v] = *(const GAS unsigned short*)(grow + ((size_t)(r_) * 128 + v) * DM); } } while (0)
#define AT_ROUND(r_, af_, g_, u_) do { \
            const int tl = 128 * (r_) + 16 * w + 4 * q; \
            unsigned uu_[4]; _Pragma("unroll") for (int v = 0; v < 4; ++v) uu_[v] = *(const GAS unsigned short*)(urow + ((size_t)(r_) * 128 + v) * UCP);     \
            f32x4 accA = {0.f, 0.f, 0.f, 0.f}, accX = {0.f, 0.f, 0.f, 0.f}; \
            if (!(AT16_VAR & 2)) { _Pragma("unroll") for (int kk = 0; kk < 8; ++kk) { accA = __builtin_amdgcn_mfma_f32_16x16x32_bf16(af_[kk], wa[kk], accA, 0, 0, 0); accX = __builtin_amdgcn_mfma_f32_16x16x32_bf16(af_[kk], wx[kk], accX, 0, 0, 0); } } else { accA[0] = __builtin_bit_cast(float, af_[0][0] | (af_[7][1] << 8)); accX[1] = __builtin_bit_cast(float, (int)af_[3][2]); } \
            float av[4], bv[4]; \
            _Pragma("unroll") for (int v = 0; v < 4; ++v) { \
                const float uval = __builtin_bit_cast(float, uu_[v] << 16); \
                if (!(AT16_VAR & 4)) { const float rg = sigmoid_f(accA[v] + ba), ii = sigmoid_f(accX[v] + bx); \
                const float aa = __builtin_amdgcn_exp2f(cl2 * rg); \
                const float om = __builtin_fmaf(-aa, aa, 1.0f); \
                av[v] = aa; bv[v] = __builtin_amdgcn_sqrtf(om) * (ii * uval); } else { av[v] = accA[v] * 0.5f + ba; bv[v] = accX[v] * uval + bx; } } \
            float A = av[0], Hh = bv[0]; \
            _Pragma("unroll") for (int v = 1; v < 4; ++v) { Hh = av[v] * Hh + bv[v]; A = A * av[v]; } \
            { const float A1 = __shfl_up(A, 16), H1 = __shfl_up(Hh, 16); if (q >= 1) { Hh = A * H1 + Hh; A = A * A1; } } \
            { const float A2 = __shfl_up(A, 32), H2 = __shfl_up(Hh, 32); if (q >= 2) { Hh = A * H2 + Hh; A = A * A2; } } \
            float Aex = __shfl_up(A, 16), Hex = __shfl_up(Hh, 16); if (q == 0) { Aex = 1.0f; Hex = 0.0f; } \
            LAS f32x2v* agr = AGL + ((r_) & 1) * 128; \
            if (q == 3) agr[w * 16 + j] = (f32x2v){A, Hh}; \
            asm volatile("s_waitcnt lgkmcnt(0)" ::: "memory"); if (!(AT16_VAR & 1)) __builtin_amdgcn_s_barrier(); asm volatile("" ::: "memory"); \
            f32x2v ag[8]; _Pragma("unroll") for (int e = 0; e < 8; ++e) ag[e] = agr[e * 16 + j]; \
            float cfull = C, cin = C; \
            _Pragma("unroll") for (int e = 0; e < 8; ++e) { cin = (e == w) ? cfull : cin; cfull = ag[e].x * cfull + ag[e].y; } \
            C = cfull; \
            float h = Aex * cin + Hex; \
            _Pragma("unroll") for (int v = 0; v < 4; ++v) { h = av[v] * h + bv[v]; \
                const float g = __builtin_bit_cast(float, g_[v] << 16); \
                if (!(AT16_VAR & 8) || h * g == 123.456f) *(GAS unsigned short*)(Y + (size_t)(tl + v) * ypitch + ch) = (unsigned short)(cvtpk(h * g, 0.f) & 0xffffu); } } while (0)
        bf16x8 af2[8]; unsigned g2[4], u2[4];
        AT_LOAD(0, af0, g0, u0); AT_LOAD(1, af1, g1, u1);
        __syncthreads();
        constexpr int NR = SEQ / 128;
#pragma unroll 1
        for (int r = 0; r < NR; r += 3) {
            if (r + 2 < NR) AT_LOAD(r + 2, af2, g2, u2);
            __builtin_amdgcn_sched_barrier(0);
            AT_ROUND(r, af0, g0, u0);
            __builtin_amdgcn_sched_barrier(0);
            if (r + 1 < NR) { if (r + 3 < NR) AT_LOAD(r + 3, af0, g0, u0);
                __builtin_amdgcn_sched_barrier(0);
                AT_ROUND(r + 1, af1, g1, u1); }
            __builtin_amdgcn_sched_barrier(0);
            if (r + 2 < NR) { if (r + 4 < NR) AT_LOAD(r + 4, af1, g1, u1);
                __builtin_amdgcn_sched_barrier(0);
                AT_ROUND(r + 2, af2, g2, u2); }
        }
#undef AT_LOAD
#undef AT_ROUND
        __syncthreads();
    }
}

constexpr int KP = 144, KBYTES = 192 * KP, ABUF = 2 * KBYTES;
__device__ __forceinline__ int crow(int reg, int h) { return (reg & 3) + 8 * (reg >> 2) + 4 * h; }
__device__ __forceinline__ void attn_phase(Frame& F, const Args& a) {
    LAS unsigned char* base = F.lds + RING_OFF;
    const int tid = F.tid, lane = F.lane, w = F.wave, r = lane & 31, hh = lane >> 5;
    const int i16 = lane & 15, q4 = i16 >> 2, p4 = i16 & 3, blk = (lane >> 4) & 1;
    const bf16* Q = (const bf16*)(a.ws + WS_Q); bf16* YA = (bf16*)(a.ws + WS_Y2) + DM; const bf16* Kg = (const bf16*)(a.ws + WS_K); const bf16* Vg = (const bf16*)(a.ws + WS_V); const bf16* GA = (const bf16*)(a.ws + WS_GA);
    constexpr int NUNITS = NKVH * (SEQ / 64);
    const int G = F.G;
    if ((int)blockIdx.x >= NUNITS) return;
    const int nloc = (NUNITS - (int)blockIdx.x + G - 1) / G;
    v4u pk[3], pv[3];
#define ATT_LOAD(u) do { const int hk_ = (u) >> 8, q0_ = 64 * ((u) & 255); _Pragma("unroll") for (int i = 0; i < 3; ++i) { const int p = tid + 512 * i, row = p >> 3, pc = p & 7, t = q0_ - 128 + row; \
            if (t >= 0) { pk[i] = *(const GAS v4u*)(Kg + (size_t)t * DKV + hk_ * HD + pc * 8); pv[i] = *(const GAS v4u*)(Vg + (size_t)t * DKV + hk_ * HD + pc * 8); } \
            else { pk[i] = (v4u){0u, 0u, 0u, 0u}; pv[i] = (v4u){0u, 0u, 0u, 0u}; } } } while (0)
#define ATT_WRITE(buf) do { _Pragma("unroll") for (int i = 0; i < 3; ++i) { const int p = tid + 512 * i, row = p >> 3, pc = p & 7; \
            *(LAS v4u*)(base + (buf) * ABUF + row * KP + pc * 16) = pk[i]; *(LAS v4u*)(base + (buf) * ABUF + KBYTES + row * KP + pc * 16) = pv[i]; } } while (0)
#define ATT_Q(it_, qt_, bq_) do { const int u_ = (it_) * G + (int)blockIdx.x, q0w_ = 64 * (u_ & 255) + 32 * (qt_), head_ = (u_ >> 8) * 8 + w; \
            const GAS bf16x8* qp_ = (const GAS bf16x8*)(Q + (size_t)(q0w_ + r) * DM + head_ * HD + 8 * hh); _Pragma("unroll") for (int s_ = 0; s_ < 4; ++s_) bq_[s_] = qp_[2 * s_]; } while (0)
#define ATT_TASK(it_, qt_, bq_) do { \
        const int u = (it_) * G + (int)blockIdx.x; \
        const LAS unsigned char* Kb = base + ((it_) & 1) * ABUF; const LAS unsigned char* Vb = Kb + KBYTES; \
        const int hk = u >> 8, q0 = 64 * (u & 255), head = hk * 8 + w; \
        const float sink2 = SK[head] * LOG2E; \
        const int q0w = q0 + 32 * (qt_); \
        v4u gq_[4];     \
        _Pragma("unroll") for (int p = 0; p < 4; ++p) gq_[p] = *(const GAS v4u*)(GA + (size_t)(q0w + r) * DM + head * HD + 16 * p + 8 * hh); \
        f32x16 x[5]; \
        _Pragma("unroll") for (int jt = 0; jt < 5; ++jt) { \
            _Pragma("unroll") for (int i = 0; i < 16; ++i) x[jt][i] = 0.f; \
            _Pragma("unroll") for (int s = 0; s < 4; ++s) { const bf16x8 kf = *(const LAS bf16x8*)(Kb + (32 * (qt_) + 32 * jt + r) * KP + (16 * s + 8 * hh) * 2); \
                x[jt] = __builtin_amdgcn_mfma_f32_32x32x16_bf16(kf, bq_[s], x[jt], 0, 0, 0); } } \
          \
        const int jt_min = (q0w >= 128) ? 0 : (4 - (q0w >> 5)); \
        const float NEG = -__builtin_inff(); \
        float m = sink2; \
        _Pragma("unroll") for (int jt = 0; jt < 5; ++jt) { \
            _Pragma("unroll") for (int i = 0; i < 16; ++i) { const int cr = crow(i, hh); bool ok = jt >= jt_min; if (jt == 0) ok = ok && (cr > r); if (jt == 4) ok = ok && (cr <= r); \
                const float v = ok ? x[jt][i] : NEG; x[jt][i] = v; m = fmaxf(m, v); } } \
        m = fmaxf(m, __shfl_xor(m, 32)); \
        float l = 0.f; \
        _Pragma("unroll") for (int jt = 0; jt < 5; ++jt) { \
            _Pragma("unroll") for (int i = 0; i < 16; ++i) { const float p = __builtin_amdgcn_exp2f(x[jt][i] - m); x[jt][i] = p; l += p; } } \
        l += __shfl_xor(l, 32); l += __builtin_amdgcn_exp2f(sink2 - m); \
        f32x16 o[2]; \
        _Pragma("unroll") for (int i = 0; i < 16; ++i) { o[0][i] = 0.f; o[1][i] = 0.f; } \
        _Pragma("unroll") for (int jt = 0; jt < 5; ++jt) { \
            _Pragma("unroll") for (int s = 0; s < 2; ++s) { \
                v4u pw; pw.x = cvtpk(x[jt][8 * s + 0], x[jt][8 * s + 1]); pw.y = cvtpk(x[jt][8 * s + 2], x[jt][8 * s + 3]); pw.z = cvtpk(x[jt][8 * s + 4], x[jt][8 * s + 5]); pw.w = cvtpk(x[jt][8 * s + 6], x[jt][8 * s + 7]); \
                const bf16x8 pf = __builtin_bit_cast(bf16x8, pw); \
                _Pragma("unroll") for (int dt = 0; dt < 2; ++dt) { \
                    const LAS unsigned char* vp = Vb + (32 * (qt_) + 32 * jt + 16 * s + 4 * hh + q4) * KP + (32 * dt + 16 * blk) * 2 + 8 * p4; \
                    const s16x4 lo = __builtin_bit_cast(s16x4, __builtin_amdgcn_ds_read_tr16_b64_v4i16((LAS s16x4*)vp)); \
                    const s16x4 hi = __builtin_bit_cast(s16x4, __builtin_amdgcn_ds_read_tr16_b64_v4i16((LAS s16x4*)(vp + 8 * KP))); \
                    const bf16x8 vf = __builtin_shufflevector(lo, hi, 0, 1, 2, 3, 4, 5, 6, 7); \
                    o[dt] = __builtin_amdgcn_mfma_f32_32x32x16_bf16(vf, pf, o[dt], 0, 0, 0); } } } \
        const float inv = 1.0f / l; \
          \
        _Pragma("unroll") for (int p = 0; p < 4; ++p) { \
            v4u gq = gq_[p];     \
            { auto t0 = __builtin_amdgcn_permlane32_swap(gq.x, gq.z, false, false); gq.x = t0[0]; gq.z = t0[1]; auto t1 = __builtin_amdgcn_permlane32_swap(gq.y, gq.w, false, false); gq.y = t1[0]; gq.w = t1[1]; } \
            const int ka = 2 * p, kb = 2 * p + 1; \
            v2u oa, ob; \
            oa.x = cvtpk(o[ka >> 2][4 * (ka & 3) + 0] * inv * bflo(gq.x), o[ka >> 2][4 * (ka & 3) + 1] * inv * bfhi(gq.x)); oa.y = cvtpk(o[ka >> 2][4 * (ka & 3) + 2] * inv * bflo(gq.y), o[ka >> 2][4 * (ka & 3) + 3] * inv * bfhi(gq.y)); \
            ob.x = cvtpk(o[kb >> 2][4 * (kb & 3) + 0] * inv * bflo(gq.z), o[kb >> 2][4 * (kb & 3) + 1] * inv * bfhi(gq.z)); ob.y = cvtpk(o[kb >> 2][4 * (kb & 3) + 2] * inv * bflo(gq.w), o[kb >> 2][4 * (kb & 3) + 3] * inv * bfhi(gq.w)); \
            { auto t0 = __builtin_amdgcn_permlane32_swap(oa.x, ob.x, false, false); oa.x = t0[0]; ob.x = t0[1]; auto t1 = __builtin_amdgcn_permlane32_swap(oa.y, ob.y, false, false); oa.y = t1[0]; ob.y = t1[1]; } \
            *(GAS v4u*)(YA + (size_t)(q0w + r) * (2 * DM) + head * HD + 16 * p + 8 * hh) = (v4u){oa.x, oa.y, ob.x, ob.y}; } } while (0)
    __syncthreads();
    ATT_LOAD((int)blockIdx.x); ATT_WRITE(0);
    LAS float* SK = (LAS float*)(base + 2 * ABUF);
    if (tid < NQH) SK[tid] = a.in[13][tid];
    bf16x8 bqA[4], bqB[4];
    ATT_Q(0, 0, bqA);
    __syncthreads();
#pragma unroll 1
    for (int it = 0; it < nloc; ++it) {
        const bool has_next = (it + 1) < nloc;
        if (has_next) ATT_LOAD((it + 1) * G + (int)blockIdx.x);
        ATT_Q(it, 1, bqB);
        __builtin_amdgcn_sched_barrier(0);
        ATT_TASK(it, 0, bqA);
        __builtin_amdgcn_sched_barrier(0);
        if (has_next) ATT_Q(it + 1, 0, bqA);
        __builtin_amdgcn_sched_barrier(0);
        ATT_TASK(it, 1, bqB);
        __builtin_amdgcn_sched_barrier(0);
        if (has_next) ATT_WRITE((it + 1) & 1);
        __syncthreads();
    }
    if (I8A && G == SEQ / 64) {
        __builtin_amdgcn_fence(__ATOMIC_RELEASE, "workgroup"); __syncthreads(); __builtin_amdgcn_fence(__ATOMIC_ACQUIRE, "workgroup");
        unsigned char* yb = (unsigned char*)(a.ws + WS_Y2) + 2 * DM; GAS float* RSo = (GAS float*)(F.ctl + CW_RS2);
        const int m0 = 64 * (int)blockIdx.x + 8 * w;
        v4u rawA[8], rawB[8];
        quant_row4096_load(rawA, yb + (size_t)m0 * (4 * DM), lane);
#pragma unroll 1
        for (int i = 0; i < 8; i += 2) {
            quant_row4096_load(rawB, yb + (size_t)(m0 + i + 1) * (4 * DM), lane);
            __builtin_amdgcn_sched_barrier(0);
            { const float sc = quant_row4096_finish(rawA, yb + (size_t)(m0 + i) * (4 * DM), lane); if (lane == 0) RSo[m0 + i] = sc; }
            if (i + 2 < 8) quant_row4096_load(rawA, yb + (size_t)(m0 + i + 2) * (4 * DM), lane);
            __builtin_amdgcn_sched_barrier(0);
            { const float sc = quant_row4096_finish(rawB, yb + (size_t)(m0 + i + 1) * (4 * DM), lane); if (lane == 0) RSo[m0 + i + 1] = sc; }
        }
    }
#undef ATT_LOAD
#undef ATT_WRITE
#undef ATT_Q
#undef ATT_TASK
}

#if defined(SCAN_NAIVE)
__device__ __forceinline__ void scan_naive(Frame& F, const Args& a) {
    LAS float* UL = (LAS float*)(F.lds + RING_OFF);
    const bf16* U = (const bf16*)(a.ws + WS_U); const bf16* Gr = (const bf16*)(a.ws + WS_G); bf16* Y = (bf16*)(a.ws + WS_Y2);
    const int cb = blockIdx.x, j = F.tid;
    if (cb >= NCB) return;
    const int ch = cb * CBW + (j & 255);
    const float* Wa = a.in[8] + (size_t)cb * 65536; const float* Wx = a.in[10] + (size_t)cb * 65536;
    const float ba = a.in[9][ch], bx = a.in[11][ch]; const float sp = log1pf(expf(-a.in[12][ch]));
    const float w0 = a.in[6][0 * DM + ch], w1 = a.in[6][1 * DM + ch], w2 = a.in[6][2 * DM + ch], w3 = a.in[6][3 * DM + ch], cbias = a.in[7][ch];
    float h = 0.f, u0 = 0.f, u1 = 0.f, u2 = 0.f;
    for (int t = 0; t < SEQ; ++t) {
        const float u3 = __builtin_bit_cast(float, (unsigned)U[(size_t)t * DM + ch] << 16);
        const float uc = cbias + w0 * u0 + w1 * u1 + w2 * u2 + w3 * u3; u0 = u1; u1 = u2; u2 = u3;
        __syncthreads();
        if (j < 256) UL[j] = uc;
        __syncthreads();
        if (j < 256) {
            float sa = 0.f, sx = 0.f;
            for (int k = 0; k < 256; ++k) { const float uk = UL[k]; sa += uk * Wa[k * 256 + j]; sx += uk * Wx[k * 256 + j]; }
            const float r = 1.0f / (1.0f + expf(-(sa + ba))), ii = 1.0f / (1.0f + expf(-(sx + bx)));
            const float la = -8.0f * r * sp; const float aa = expf(la);
            h = aa * h + sqrtf(-expm1f(2.0f * la)) * (ii * uc);
            const float g = __builtin_bit_cast(float, (unsigned)Gr[(size_t)t * DM + ch] << 16);
            Y[(size_t)t * (2 * DM) + ch] = (bf16)(cvtpk(h * g, 0.f) & 0xffffu);
        }
    }
}
#endif
#if defined(ATTN_NAIVE)
__device__ __forceinline__ void attn_naive(Frame& F, const Args& a) {
    const int lane = F.lane; const int gw = F.vcu * NWAVES + F.wave, NGW = F.G * NWAVES;
    const bf16* Q = (const bf16*)(a.ws + WS_Q); const bf16* Kg = (const bf16*)(a.ws + WS_K); const bf16* Vg = (const bf16*)(a.ws + WS_V); const bf16* GA = (const bf16*)(a.ws + WS_GA);
    bf16* YA = (bf16*)(a.ws + WS_Y2) + DM;
    for (int task = gw; task < SEQ * NQH; task += NGW) {
        const int t = task >> 6, head = task & 63, hk = head >> 3;
        const float sink2 = a.in[13][head] * LOG2E;
        float s[2];
#pragma unroll
        for (int e = 0; e < 2; ++e) { const int kp = t - 127 + 64 * e + lane; float acc = -__builtin_inff();
            if (kp >= 0) { acc = 0.f; for (int d = 0; d < HD; ++d) { const float qv = __builtin_bit_cast(float, (unsigned)Q[(size_t)t * DM + head * HD + d] << 16), kv = __builtin_bit_cast(float, (unsigned)Kg[(size_t)kp * DKV + hk * HD + d] << 16); acc += qv * kv; } }
            s[e] = acc; }
        float m = fmaxf(s[0], s[1]);
#pragma unroll
        for (int o = 1; o < 64; o <<= 1) m = fmaxf(m, __shfl_xor(m, o));
        m = fmaxf(m, sink2);
        const float p0 = __builtin_amdgcn_exp2f(s[0] - m), p1 = __builtin_amdgcn_exp2f(s[1] - m);
        const float l = wave_sum(p0 + p1) + __builtin_amdgcn_exp2f(sink2 - m);
        float o = 0.f;
        for (int i = 0; i < 64; ++i) { const float pa = __shfl(p0, i), pb = __shfl(p1, i); const int ka = t - 127 + i, kb = t - 63 + i;
            if (ka >= 0) o += pa * __builtin_bit_cast(float, (unsigned)Vg[(size_t)ka * DKV + hk * HD + lane] << 16);
            if (kb >= 0) o += pb * __builtin_bit_cast(float, (unsigned)Vg[(size_t)kb * DKV + hk * HD + lane] << 16); }
        const float g = __builtin_bit_cast(float, (unsigned)GA[(size_t)t * DM + head * HD + lane] << 16);
        YA[(size_t)t * (2 * DM) + head * HD + lane] = (bf16)(cvtpk(o / l * g, 0.f) & 0xffffu);
    }
}
#endif


#if defined(CHECK_G1)
__device__ __forceinline__ void check_g1(Frame& F, const Args& a) {
    const int gw = F.vcu * NWAVES + F.wave, lane = F.lane;
    const bf16* H = (const bf16*)(a.ws + WS_H); const bf16* U = (const bf16*)(a.ws + WS_U);
    float* acc = (float*)(F.ctl + CW_MOD) + 40000;
    const int row = (gw * 8191 + 37) % SEQ, col = (gw * 1021 + 5) % DM;
    double s = 0.0;
    for (int k = lane; k < DM; k += 64) s += (double)__builtin_bit_cast(float, (unsigned)H[(size_t)row * DM + k] << 16) * (double)a.in[5][(size_t)k * DIN + col];
#pragma unroll
    for (int o = 1; o < 64; o <<= 1) s += __shfl_xor(s, o);
    if (lane == 0) { const double got = (double)__builtin_bit_cast(float, (unsigned)U[(size_t)row * DM + col] << 16); const double e = got - s;
        atomicAdd(acc + 0, (float)(e * e)); atomicAdd(acc + 1, (float)(s * s)); }
}
#endif


#if defined(CHECK_MRG) || defined(CHECK_OUT)
__device__ __forceinline__ double bf2d(bf16 v) { return (double)__builtin_bit_cast(float, (unsigned)v << 16); }
__device__ __forceinline__ double wsum_d(double s) {
#pragma unroll
    for (int o = 1; o < 64; o <<= 1) s += __shfl_xor(s, o);
    return s; }
#endif
#if defined(CHECK_MRG)
__device__ __forceinline__ void check_mrg(Frame& F, const Args& a) {
    const int gw = F.vcu * NWAVES + F.wave, lane = F.lane;
    const bf16* YR = (const bf16*)(a.ws + WS_H); const bf16* YA = (const bf16*)(a.ws + WS_YA); const bf16* MR = (const bf16*)(a.ws + WS_MR); const bf16* MA = (const bf16*)(a.ws + WS_MA); const bf16* MG = (const bf16*)(a.ws + WS_MRG);
    float* acc = (float*)(F.ctl + CW_MOD) + 40000;
    const int row = (gw * 8191 + 37) % SEQ, col = (gw * 1021 + 5) % DM;
    double s1 = 0.0, s2 = 0.0;
    for (int k = lane; k < DM; k += 64) { s1 += bf2d(YR[(size_t)row * DM + k]) * (double)a.in[14][(size_t)k * DM + col]; s2 += bf2d(YA[(size_t)row * DM + k]) * (double)a.in[15][(size_t)k * DM + col]; }
    s1 = wsum_d(s1); s2 = wsum_d(s2);
    if (lane == 0) { const double ref = bf2d(MR[(size_t)row * DM + col]) * s1 + bf2d(MA[(size_t)row * DM + col]) * s2, got = bf2d(MG[(size_t)row * DM + col]), e = got - ref;
        atomicAdd(acc + 0, (float)(e * e)); atomicAdd(acc + 1, (float)(ref * ref)); }
}
#endif
#if defined(CHECK_OUT)
__device__ __forceinline__ void check_out(Frame& F, const Args& a) {
    const int gw = F.vcu * NWAVES + F.wave, lane = F.lane;
    const bf16* MG = (const bf16*)(a.ws + WS_MRG); const float* gate = (const float*)(F.ctl + CW_MOD) + 2 * DM;
    float* acc = (float*)(F.ctl + CW_MOD) + 40000;
    const int row = (gw * 8191 + 37) % SEQ, col = (gw * 1021 + 5) % DM;
    double s1 = 0.0;
    for (int k = lane; k < DM; k += 64) s1 += bf2d(MG[(size_t)row * DM + k]) * (double)a.in[16][(size_t)k * DM + col];
    s1 = wsum_d(s1);
    if (lane == 0) { const double ref = (double)gate[col] * s1, got = (double)a.out[(size_t)row * DM + col] - (double)a.in[0][(size_t)row * DM + col], e = got - ref;
        atomicAdd(acc + 0, (float)(e * e)); atomicAdd(acc + 1, (float)(ref * ref)); }
}
#endif


#if defined(CHECK_G1B)
__device__ __forceinline__ void check_g1b(Frame& F, const Args& a) {
    const int gw = F.vcu * NWAVES + F.wave, lane = F.lane;
    const bf16* H = (const bf16*)(a.ws + WS_H);
    float* acc = (float*)(F.ctl + CW_MOD) + 40000;
    constexpr int which = CHECK_G1B;
    constexpr int c0 = which == 1 ? 4096 : which == 2 ? 8192 : which == 3 ? 12288 : which == 4 ? 12800 : which == 5 ? 13312 : which == 6 ? 17408 : 21504;
    constexpr int wdt = (which == 3 || which == 4) ? 512 : 4096;
    const size_t off = which == 1 ? WS_G : which == 2 ? WS_Q : which == 3 ? WS_K : which == 4 ? WS_V : which == 5 ? WS_GA : which == 6 ? WS_MR : WS_MA;
    const bf16* T = (const bf16*)(a.ws + off);
    const int row = (gw * 8191 + 37) % SEQ, col = (gw * 1021 + 5) % wdt;
    double s = 0.0;
    for (int k = lane; k < DM; k += 64) s += (double)__builtin_bit_cast(float, (unsigned)H[(size_t)row * DM + k] << 16) * (double)a.in[5][(size_t)k * DIN + c0 + col];
#pragma unroll
    for (int o = 1; o < 64; o <<= 1) s += __shfl_xor(s, o);
    if (lane == 0) { double ref = s; if (which == 1 || which == 5) ref = s / (1.0 + exp(-s)); if (which == 6 || which == 7) ref = 1.0 / (1.0 + exp(-s)); if (which == 2) ref = s * 0.125 * 1.4426950408889634;
        const double got = (double)__builtin_bit_cast(float, (unsigned)T[(size_t)row * wdt + col] << 16); const double e = got - ref;
        atomicAdd(acc + 0, (float)(e * e)); atomicAdd(acc + 1, (float)(ref * ref)); }
}
#endif


#if defined(CHECK_H)
__device__ __forceinline__ void check_h(Frame& F, const Args& a) {
    const int gw = F.vcu * NWAVES + F.wave, lane = F.lane;
    const bf16* H = (const bf16*)(a.ws + WS_H); const float* mod = (const float*)(F.ctl + CW_MOD);
    float* acc = (float*)(F.ctl + CW_MOD) + 40000;
    const int row = (gw * 8191 + 37) % SEQ, col = (gw * 1021 + 5) % DM;
    double s = 0.0;
    for (int k = lane; k < DM; k += 64) { const double v = (double)a.in[0][(size_t)row * DM + k]; s += v * v; }
#pragma unroll
    for (int o = 1; o < 64; o <<= 1) s += __shfl_xor(s, o);
    if (lane == 0) { const double ref = (double)a.in[0][(size_t)row * DM + col] / sqrt(s / DM + 1e-6) * (double)a.in[4][col] * (1.0 + (double)mod[DM + col]) + (double)mod[col];
        const double got = (double)__builtin_bit_cast(float, (unsigned)H[(size_t)row * DM + col] << 16); const double e = got - ref;
        atomicAdd(acc + 0, (float)(e * e)); atomicAdd(acc + 1, (float)(ref * ref)); }
}
#endif

__device__ __forceinline__ void p7_final(Frame& F, const Args& a) {
    LAS float* FG = (LAS float*)(F.lds + RING_OFF);
    for (int d = F.tid; d < DM; d += NWAVES * 64) FG[d] = a.in[17][d];
    __syncthreads();
    const int gw = F.vcu * NWAVES + F.wave, NGW = F.G * NWAVES;
    const bf16* GO = (const bf16*)(a.ws + WS_GO);
#pragma unroll 1
    for (int m = gw; m < SEQ; m += NGW) {
        asm volatile("" ::: "memory");
        const GAS f32x4* xr = (const GAS f32x4*)(a.in[0] + (size_t)m * DM) + F.lane; const GAS v2u* gr = (const GAS v2u*)(GO + (size_t)m * DM) + F.lane;
        GAS f32x4* orow = (GAS f32x4*)(a.out + (size_t)m * DM) + F.lane;
        f32x4 v[16]; float s = 0.f;
#pragma unroll
        for (int j = 0; j < 16; ++j) { const v2u g = __builtin_nontemporal_load(gr + 64 * j); v[j] = __builtin_nontemporal_load(xr + 64 * j) + (f32x4){bflo(g.x), bfhi(g.x), bflo(g.y), bfhi(g.y)}; s += (v[j].x * v[j].x + v[j].y * v[j].y) + (v[j].z * v[j].z + v[j].w * v[j].w); }
        const float rstd = 1.0f / sqrtf(wave_sum(s) * (1.0f / DM) + EPS);
#pragma unroll
        for (int j = 0; j < 16; ++j) { const f32x4 g = *(const LAS f32x4*)(FG + 4 * F.lane + 256 * j); __builtin_nontemporal_store(v[j] * rstd * g, orow + 64 * j); }
    }
}

#ifndef SCAN_AT16
#define SCAN_TWOPASS 1
#endif
#ifndef SCAN_STORED
#define SCAN_RECOMPUTE 1
#endif
#ifndef GEMM_ALIGN
#define GEMM_ALIGN true
#endif
#ifndef GEMM_SP2
#define GEMM_SP2 true
#endif
#ifndef REP_P2
#define REP_P2 1
#endif
#ifndef REP_P5
#define REP_P5 1
#endif
#ifndef REP_P6
#define REP_P6 1
#endif
#ifndef REP_P3
#define REP_P3 1
#endif
#ifndef REP_P1
#define REP_P1 1
#endif
__global__ void __launch_bounds__(NWAVES * 64, 2) fwd(Args args) {
    extern __shared__ __attribute__((aligned(16))) unsigned char lds[];
    Frame F;
    F.lds = (LAS unsigned char*)lds;
    F.MISC = (volatile LAS unsigned*)(F.lds + MISC_OFF);
    F.tid = threadIdx.x; F.lane = F.tid & 63; F.wave = __builtin_amdgcn_readfirstlane(F.tid >> 6);
    F.G = gridDim.x; { const int bx = blockIdx.x; F.vcu = (F.G % 8 == 0) ? (bx % 8) * (F.G / 8) + bx / 8 : bx; }
    F.ctl = (gu32*)(args.ws + WS_CTL);
    for (int u = F.tid; u < (LDS_BYTES - LDSCTL_OFF) / 4; u += NWAVES * 64) ((LAS unsigned*)(F.lds + LDSCTL_OFF))[u] = 0u;
    __syncthreads();
    XcdBarrier bar; bar.bar = (unsigned*)(F.ctl + CW_BAR); bar.x = 0; bar.st = nullptr;
    if (N_LAUNCHES == 1) bar = xcd_barrier_post((unsigned*)(F.ctl + CW_BAR), F.MISC + 8);
#define GRID_BAR(seam) do { if (N_LAUNCHES != 1) { if (F.tid == 0) __hip_atomic_store(F.ctl + CW_TMO, 0xBADBA0u | (unsigned)(seam), RLX_AGENT); } else { xcd_barrier(bar); } } while (0)
    const int lo = args.ph_lo, hi = args.ph_hi;
#ifndef PH_MASK
#define PH_MASK 0xff
#endif
#define IN(k) (((PH_MASK >> (k)) & 1) && lo <= (k) && (k) < hi)
#define BOTH(k) (IN(k) && IN((k) + 1))
    unsigned char* ws = args.ws;

    if (IN(0)) { p0_prologue(F, args, true);
#if defined(REP_P0)
        p0_prologue(F, args, false);
#endif
        if (BOTH(0)) GRID_BAR(0); }
    if (IN(1)) { for (int rep = 0; rep < REP_P1; ++rep) { __syncthreads(); p1_hrows(F, args); } if (BOTH(1)) GRID_BAR(1); }
#define DO_P2() { \
        __syncthreads(); \
        pg8::Gemm g{(const pg8::bf16_t*)(ws + WS_H), (const pg8::bf16_t*)(ws + WS_WIN), SEQ, DIN, DM}; pg8::StaticOrder S; S.init(SEQ, DIN, F.G, (int)blockIdx.x); \
        pg8::EpiProj E{(pg8::bf16_t*)(ws + WS_U), (pg8::bf16_t*)(ws + WS_G), (pg8::bf16_t*)(ws + WS_Q), (pg8::bf16_t*)(ws + WS_K), (pg8::bf16_t*)(ws + WS_V), (pg8::bf16_t*)(ws + WS_GA), (pg8::bf16_t*)(ws + WS_MR), (pg8::bf16_t*)(ws + WS_MA), QSCALE}; \
        if (F8Q == 1 || F8Q == 2) { g.A8 = ws + WS_H8; g.B8 = ws + WS_WQ8; if (F8Q == 1) { g.f8_mask = E.f8_mask = F8_MASK; E.f8inv = 1.0f / WQ8_SCALE; if (I8Q) { E.RS = (const float*)(F.ctl + CW_RS); E.CS = (const float*)(F.ctl + CW_CS); E.BIAS = (const float*)(F.ctl + CW_BIAS); } }     \
            pg8::gemm_phase_mixed<pg8::EpiProj, pg8::StaticOrder, (I8Q != 0)>(F.lds + RING_OFF, g, S, E); } \
        else pg8::gemm_phase<pg8::EpiProj, pg8::StaticOrder, GEMM_ALIGN, GEMM_SP2>(F.lds + RING_OFF, g, S, E); }
#if defined(PROBE_GEMM_K)
#ifndef PROBE_LD
#define PROBE_LD DM
#endif
#ifndef PROBE_AMASK
#define PROBE_AMASK 0x7fffffff
#define PROBE_BMASK 0x7fffffff
#endif
    if (IN(2)) { __syncthreads();
        pg8::Gemm g{(const pg8::bf16_t*)(ws + WS_H), (const pg8::bf16_t*)(ws + WS_WIN), SEQ, PROBE_GEMM_N, PROBE_GEMM_K, PROBE_LD, PROBE_AMASK, PROBE_BMASK}; pg8::StaticOrder S; S.init(SEQ, PROBE_GEMM_N, F.G, (int)blockIdx.x);
        pg8::EpiDummy E{(pg8::bf16_t*)(ws + WS_Y2)};
        pg8::gemm_phase<pg8::EpiDummy, pg8::StaticOrder, GEMM_ALIGN, GEMM_SP2>(F.lds + RING_OFF, g, S, E); }
#endif
    if (IN(2)) { DO_P2()
#if REP_P2 >= 2
        DO_P2()
#endif
        if (BOTH(2)) GRID_BAR(2);
    }
#if defined(CHECK_G1)
    if (IN(3)) check_g1(F, args);
#endif
#if defined(CHECK_G1B)
    if (IN(3)) check_g1b(F, args);
#endif
#if defined(CHECK_H)
    if (IN(3)) check_h(F, args);
#endif
#if defined(SCAN_NAIVE)
    if (IN(3)) { scan_naive(F, args); if (BOTH(3)) GRID_BAR(3); }
#else
#if defined(SCAN_DMA)
    if (IN(3)) { conv_pass(F, args); GRID_BAR(30); scan_dma<1, SCAN_DMA>(F, args, (float*)(ws + WS_AGG)); if (BOTH(3)) GRID_BAR(3); }
#elif defined(SCAN_TWOPASS)
    if (IN(3)) { for (int rep = 0; rep < REP_P3; ++rep) scan_pass<1>(F, args, (float*)(ws + WS_AGG));
#if defined(SCAN_PROBE)
        scan_pass<1, SCAN_PROBE>(F, args, (float*)(ws + WS_AGG + 512 * 1024));
#endif
        if (BOTH(3)) GRID_BAR(3); }
#else
    if (IN(3)) { conv_pass(F, args); if (BOTH(3)) GRID_BAR(3); }
#endif
#endif
    #if defined(ATTN_NAIVE)
    if (IN(4)) { scan_pass<2>(F, args, (float*)(ws + WS_AGG)); attn_naive(F, args);
#else
#if defined(SCAN_DMA)
    if (IN(4)) { scan_dma<2, SCAN_DMA>(F, args, (float*)(ws + WS_AGG)); attn_phase(F, args);
#elif defined(SCAN_TWOPASS)
#if defined(SCAN_RECOMPUTE)
    if (IN(4)) { scan_pass<2>(F, args, (float*)(ws + WS_AGG)); attn_phase(F, args);
#if defined(AT16_PROBE)
        conv_pass(F, args); GRID_BAR(40);
#if AT16_PROBE > 0
        scan_at16(F, args, (bf16*)(ws + WS_H), DM);
#endif
#endif
#else
    if (IN(4)) { scan_light(F, args); attn_phase(F, args);
#endif
#else
    if (IN(4)) { scan_at16(F, args, (bf16*)(ws + WS_Y2), 2 * DM); attn_phase(F, args);
#endif
#if defined(REP_ATT)
        attn_phase(F, args);
#endif
#endif
 if (BOTH(4)) GRID_BAR(4); }
#define DO_P5() { __syncthreads(); \
        pg8::Gemm g{(const pg8::bf16_t*)(ws + WS_Y2), (const pg8::bf16_t*)(ws + WS_WCAT), SEQ, DM, 2 * DM}; pg8::StaticOrder S; S.init(SEQ, DM, F.G, (int)blockIdx.x); \
        if (I8A) { pg8::EpiMergeT<true> E{(const pg8::bf16_t*)(ws + WS_MA), (const pg8::bf16_t*)(ws + WS_MR), (pg8::bf16_t*)(ws + WS_MRG), (const float*)(F.ctl + CW_RS2), (const float*)(F.ctl + CW_CS2)};     \
            pg8::gemm_phase_split<pg8::EpiMergeT<true>, pg8::StaticOrder>(F.lds + RING_OFF, g, S, E, DM / 128, DM / 64, (size_t)(2 * DM)); } \
        else { pg8::EpiMerge E{(const pg8::bf16_t*)(ws + WS_MR), (const pg8::bf16_t*)(ws + WS_MA), (pg8::bf16_t*)(ws + WS_MRG)}; \
        pg8::gemm_phase<pg8::EpiMerge, pg8::StaticOrder, GEMM_ALIGN, GEMM_SP2>(F.lds + RING_OFF, g, S, E); } }
    if (IN(5)) {
#if defined(P5_STAGGER)
        if ((blockIdx.x & 7) >= 4) { const unsigned long long t0 = __builtin_amdgcn_s_memrealtime(); while (__builtin_amdgcn_s_memrealtime() - t0 < (unsigned long long)(P5_STAGGER)) __builtin_amdgcn_s_sleep(8); }
#endif
        if (I8A && F.G != SEQ / 64) { p4q_rows(F, args); GRID_BAR(45); }
        DO_P5()
#if defined(REP_P5X)
        DO_P5()
#endif
        if (BOTH(5)) GRID_BAR(5);
    }
#if defined(MOD_NAIVE)
#define GATE_PTR ((const float*)(F.ctl + CW_MOD) + 3 * DM + 64 + 2 * DM)
#else
#define GATE_PTR ((const float*)(F.ctl + CW_MOD) + 2 * DM)
#endif
#define DO_P6() { __syncthreads(); \
        pg8::Gemm g{(const pg8::bf16_t*)(ws + WS_MRG), (const pg8::bf16_t*)(ws + WS_WOUT), SEQ, DM, DM}; pg8::StaticOrder S; S.init(SEQ, DM, F.G, (int)blockIdx.x); \
        pg8::EpiOut E{GATE_PTR, (pg8::bf16_t*)(ws + WS_GO)}; \
        pg8::gemm_phase<pg8::EpiOut, pg8::StaticOrder, GEMM_ALIGN, GEMM_SP2>(F.lds + RING_OFF, g, S, E); }
    if (IN(6)) {
#if defined(CHECK_MRG)
        check_mrg(F, args);
#endif
        DO_P6()
#if defined(REP_P6X)
        DO_P6()
#endif
        if (BOTH(6)) GRID_BAR(6);
    }
    if (IN(7)) { __syncthreads();
#if defined(CHECK_OUT)
        check_out(F, args); GRID_BAR(7);
#endif
        p7_final(F, args);
#if defined(CHECK_G1) || defined(CHECK_MRG) || defined(CHECK_OUT) || defined(CHECK_G1B) || defined(CHECK_H)
        if (blockIdx.x == 0 && F.tid == 0) { const float* acc = (const float*)(F.ctl + CW_MOD) + 40000; args.out[0] += 1.0e4f * sqrtf(acc[0] / acc[1]); }
#endif
    }
#undef IN
#undef BOTH
}

extern "C" void kernel_launch(void* const* d_in, const int* in_sizes, int n_in, void* d_out, int out_size, void* d_ws, size_t ws_size, hipStream_t stream) {
    static int grid = 0;
    if (grid == 0) {
        if (n_in != 18 || in_sizes[0] != SEQ * DM || out_size != SEQ * DM || ws_size < WS_END) { fprintf(stderr, "kernel_launch: unexpected shapes (n_in %d, in0 %d, out %d, ws %zu); nothing launched\n", n_in, n_in > 0 ? in_sizes[0] : -1, out_size, ws_size); grid = -1; return; }
        int dev = 0, cus = 0, per_cu = 0;
        if (hipGetDevice(&dev) != hipSuccess || hipDeviceGetAttribute(&cus, hipDeviceAttributeMultiprocessorCount, dev) != hipSuccess) { grid = -1; return; }
        if (hipFuncSetAttribute((const void*)fwd, hipFuncAttributeMaxDynamicSharedMemorySize, LDS_BYTES) != hipSuccess) { fprintf(stderr, "kernel_launch: hipFuncSetAttribute failed\n"); grid = -1; return; }
        if (hipOccupancyMaxActiveBlocksPerMultiprocessor(&per_cu, (const void*)fwd, NWAVES * 64, LDS_BYTES) != hipSuccess || per_cu < 1) fprintf(stderr, "kernel_launch: note: occupancy query reports %d workgroups per CU\n", per_cu);
        (void)hipGetLastError();
        grid = cus;
    }
    if (grid < 0) return;
    if (hipMemsetAsync((char*)d_ws + WS_CTL, 0, CTL_ZERO_BYTES, stream) != hipSuccess) return;
    Args a{};
    for (int i = 0; i < 18; ++i) a.in[i] = (const float*)d_in[i];
    a.out = (float*)d_out; a.ws = (unsigned char*)d_ws;
    if (N_LAUNCHES == 1) { a.ph_lo = 0; a.ph_hi = N_PHASES; hipLaunchKernelGGL(fwd, dim3(grid), dim3(NWAVES * 64), LDS_BYTES, stream, a); }
    else for (int li = 0; li < N_PHASES; ++li) { a.ph_lo = li; a.ph_hi = li + 1; hipLaunchKernelGGL(fwd, dim3(grid), dim3(NWAVES * 64), LDS_BYTES, stream, a); }
}
```

```cpp
#define F8Q 1
#include <hip/hip_runtime.h>
#include <cstdio>
#include <cstdint>
namespace pg8 {
#define PG8_LAS __attribute__((address_space(3)))
typedef unsigned short bf16_t;
typedef short bf16x8 __attribute__((ext_vector_type(8)));
typedef float f32x4 __attribute__((ext_vector_type(4)));
typedef unsigned u32x4 __attribute__((ext_vector_type(4)));
constexpr int BM = 256, BK = 64, HALF = 128, HTB = HALF * BK * 2  , STAGE_BYTES = 8 * HTB, NXCD = 8;
#ifndef PG8_WGM
#define PG8_WGM 8
#endif
constexpr int WGM = PG8_WGM;

__host__ __device__ __forceinline__ int lds_byte(int r, int c) { const int st = (r >> 4) * 2 + (c >> 5), rr = r & 15, cc = c & 31, ob = rr * 64 + cc * 2; return st * 1024 + (ob ^ (((ob >> 9) & 1) << 5)); }
__host__ __device__ __forceinline__ void stage_rc(int b, int& R, int& C) { const int st = b / 1024, sb = b % 1024, swz = sb ^ (((sb >> 9) & 1) << 5); R = (st >> 1) * 16 + swz / 64; C = (st & 1) * 32 + (swz % 64) / 2; }
__host__ __device__ __forceinline__ int perm32(int rho) { const int n = rho >> 4, i = rho & 15; return 8 * (i >> 2) + 4 * n + (i & 3); }

__host__ __device__ __forceinline__ int f8_slot(int pn, unsigned mask) {
    int slot = 0; const int nmr = (int)((mask >> 8) & 31u);
    const int mr_hi = nmr ? 68 + nmr : 84; const int nu = (int)((mask >> 13) & 31u), u_hi = nu ? nu : 16, ng = (int)((mask >> 18) & 31u), g_hi = ng ? 16 + ng : 32;
#define F8_SEG(s, lo, hi) if (pn < (hi)) return ((mask >> (s)) & 1u) ? slot + pn - (lo) : -1; if ((mask >> (s)) & 1u) slot += (hi) - (lo);
    F8_SEG(0, 0, u_hi) F8_SEG(7, u_hi, 16) F8_SEG(1, 16, g_hi) F8_SEG(7, g_hi, 32) F8_SEG(2, 32, 48) F8_SEG(3, 48, 52) F8_SEG(4, 52, 68) F8_SEG(5, 68, mr_hi) F8_SEG(7, mr_hi, 84) F8_SEG(6, 84, 100)
#undef F8_SEG
    return -1;
}
__host__ __device__ __forceinline__ int f8_tile(int slot, unsigned mask) {
    const int nmr = (int)((mask >> 8) & 31u), mr_hi = nmr ? 68 + nmr : 84, nu = (int)((mask >> 13) & 31u), u_hi = nu ? nu : 16, ng = (int)((mask >> 18) & 31u), g_hi = ng ? 16 + ng : 32;
#define F8_SEG(s, lo, hi) if ((mask >> (s)) & 1u) { if (slot < (hi) - (lo)) return (lo) + slot; slot -= (hi) - (lo); }
    F8_SEG(0, 0, u_hi) F8_SEG(1, 16, g_hi) F8_SEG(2, 32, 48) F8_SEG(3, 48, 52) F8_SEG(4, 52, 68) F8_SEG(5, 68, mr_hi) F8_SEG(6, 84, 100)
#undef F8_SEG
    return -1;
}
__host__ __device__ constexpr int f8_count(unsigned mask) {
    const int nmr = (int)((mask >> 8) & 31u), mr_hi = nmr ? 68 + nmr : 84, nu = (int)((mask >> 13) & 31u), u_hi = nu ? nu : 16, ng = (int)((mask >> 18) & 31u), g_hi = ng ? 16 + ng : 32; int c = 0;
#define F8_SEG(s, lo, hi) if ((mask >> (s)) & 1u) c += (hi) - (lo);
    F8_SEG(0, 0, u_hi) F8_SEG(1, 16, g_hi) F8_SEG(2, 32, 48) F8_SEG(3, 48, 52) F8_SEG(4, 52, 68) F8_SEG(5, 68, mr_hi) F8_SEG(6, 84, 100)
#undef F8_SEG
    return c;
}
struct Unit { int pm, pn; };
struct Gemm { const bf16_t* A; const bf16_t* Bt; int M, N, K; int ld = 0; int amask = 0x7fffffff, bmask = 0x7fffffff; const unsigned char* A8 = nullptr; const unsigned char* B8 = nullptr; unsigned f8_mask = 0u; };

struct StaticOrder {
    int nM, nN, nwg, G, c;
    __host__ __device__ void init(int M, int N, int G_, int c_) { nM = M / BM; nN = N / BM; nwg = nM * nN; G = G_; c = c_; }
    __host__ __device__ bool next(int i, Unit& u) const {
        const long L = (long)i * G + c; if (L >= nwg) return false;
        int wgid = (int)L; { const int q = nwg / NXCD, r = nwg % NXCD, xcd = wgid % NXCD, off = wgid / NXCD; wgid = (xcd < r ? xcd * (q + 1) : r * (q + 1) + (xcd - r) * q) + off; }
        const int nig = WGM * nN, gid = wgid / nig, fm = gid * WGM, gsz = (nM - fm) < WGM ? (nM - fm) : WGM;
        u.pm = fm + ((wgid % nig) % gsz); u.pn = (wgid % nig) / gsz; return true;
    }
    __device__ __forceinline__ void a_ready(const Unit&) const {}
    __device__ __forceinline__ void done(const Unit&) const {}
};

__device__ __forceinline__ unsigned cvt_pk_bf16(float lo, float hi) { unsigned r; asm volatile("v_cvt_pk_bf16_f32 %0, %1, %2" : "=v"(r) : "v"(lo), "v"(hi)); return r; }
typedef float f32x2 __attribute__((ext_vector_type(2)));

typedef __bf16 bf16x2_t __attribute__((ext_vector_type(2)));
typedef unsigned u32x2e __attribute__((ext_vector_type(2)));
#ifndef GATE_U8
#define GATE_U8 0
#endif
__device__ __forceinline__ float ub(unsigned w, int k) { return (float)((w >> (8 * k)) & 0xffu); }
__device__ __forceinline__ unsigned cvtpk(float lo, float hi) { f32x2 v = {lo, hi}; bf16x2_t b = __builtin_convertvector(v, bf16x2_t); return __builtin_bit_cast(unsigned, b); }
__device__ __forceinline__ float bflo(unsigned w) { return __builtin_bit_cast(float, w << 16); }
__device__ __forceinline__ float bfhi(unsigned w) { return __builtin_bit_cast(float, w & 0xffff0000u); }
__device__ __forceinline__ float sigmoid_f(float x) { return __builtin_amdgcn_rcpf(1.0f + __builtin_amdgcn_exp2f(x * -1.4426950408889634f)); }

typedef int i32x4e __attribute__((ext_vector_type(4)));
struct EpiProj {
    static constexpr bool PERM = true, AFTER_DRAIN = false, HAS_MID = false;
    bf16_t *U, *G, *Q, *K, *V, *GA, *MR, *MA; float qscale; float f8inv = 1.0f; unsigned f8_mask = 0u; const float* RS = nullptr; const float* CS = nullptr; const float* BIAS = nullptr;
    __device__ __forceinline__ void operator()(const f32x4 (&acc)[2][2][4][2], const Unit& u, int wr, int wc, int fr, int fq) const {
        const int pn = u.pn; bf16_t* base; int ldc = 4096, colt, act;
        if (pn < 16) { base = U; colt = pn; act = 0; } else if (pn < 32) { base = G; colt = pn - 16; act = 1; } else if (pn < 48) { base = Q; colt = pn - 32; act = 3; }
        else if (pn < 50) { base = K; colt = pn - 48; act = 0; ldc = 512; } else if (pn < 52) { base = V; colt = pn - 50; act = 0; ldc = 512; }
        else if (pn < 68) { base = GA; colt = pn - 52; act = 1; } else if (pn < 84) { base = MR; colt = pn - 68; act = 2; } else { base = MA; colt = pn - 84; act = 2; }
        const int row0 = u.pm * BM + wr * 64 + fr, col0 = colt * BM + wc * 32 + 8 * fq;
        const bool lowp = f8_slot(pn, f8_mask) >= 0, isq = lowp && RS != nullptr;
        const float pre = (lowp && !isq) ? f8inv : 1.0f, qs = qscale * pre;
        float rsv[2][4]; f32x4 csv[2][2], bsv[2][2];
        if (isq) {
            const int gc0 = pn * BM + wc * 32 + 8 * fq;
#pragma unroll
            for (int ai = 0; ai < 2; ++ai)
#pragma unroll
                for (int m = 0; m < 4; ++m) rsv[ai][m] = RS[row0 + ai * HALF + m * 16];
#pragma unroll
            for (int bj = 0; bj < 2; ++bj)
#pragma unroll
                for (int n = 0; n < 2; ++n) { csv[bj][n] = *(const f32x4*)(CS + gc0 + bj * HALF + 4 * n); bsv[bj][n] = *(const f32x4*)(BIAS + gc0 + bj * HALF + 4 * n); }
        } else {
#pragma unroll
            for (int ai = 0; ai < 2; ++ai)
#pragma unroll
                for (int m = 0; m < 4; ++m) rsv[ai][m] = 0.f;
#pragma unroll
            for (int bj = 0; bj < 2; ++bj)
#pragma unroll
                for (int n = 0; n < 2; ++n) { csv[bj][n] = (f32x4){0.f, 0.f, 0.f, 0.f}; bsv[bj][n] = (f32x4){0.f, 0.f, 0.f, 0.f}; }
        }
#pragma unroll
        for (int ai = 0; ai < 2; ++ai)
#pragma unroll
            for (int m = 0; m < 4; ++m) { bf16_t* rowp = base + (size_t)(row0 + ai * HALF + m * 16) * ldc + col0;
#pragma unroll
                for (int bj = 0; bj < 2; ++bj) { f32x4 v0 = acc[ai][bj][m][0], v1 = acc[ai][bj][m][1];
                    if (isq) {
                        const i32x4e i0 = __builtin_bit_cast(i32x4e, v0), i1 = __builtin_bit_cast(i32x4e, v1);
#pragma unroll
                        for (int j = 0; j < 4; ++j) { v0[j] = (float)i0[j] * (rsv[ai][m] * csv[bj][0][j]) + bsv[bj][0][j]; v1[j] = (float)i1[j] * (rsv[ai][m] * csv[bj][1][j]) + bsv[bj][1][j]; } }
                    else if (act == 1 || act == 2) { v0 = v0 * pre; v1 = v1 * pre; }
                    if (act == 1) {
#pragma unroll
                        for (int j = 0; j < 4; ++j) { v0[j] = v0[j] * sigmoid_f(v0[j]); v1[j] = v1[j] * sigmoid_f(v1[j]); } }
                    else if (act == 2) {
#pragma unroll
                        for (int j = 0; j < 4; ++j) { v0[j] = fmaxf(sigmoid_f(v0[j]), 1e-30f); v1[j] = fmaxf(sigmoid_f(v1[j]), 1e-30f); } }
                    else if (act == 3) { v0 = v0 * qs; v1 = v1 * qs; }
#if GATE_U8
                    if (act == 2) {
                        unsigned lo = 0u, hi = 0u;
#pragma unroll
                        for (int j = 0; j < 4; ++j) { lo |= (unsigned)fminf(fmaxf(__builtin_rintf(v0[j] * 255.0f), 1.0f), 255.0f) << (8 * j); hi |= (unsigned)fminf(fmaxf(__builtin_rintf(v1[j] * 255.0f), 1.0f), 255.0f) << (8 * j); }
                        *(u32x2e*)((unsigned char*)base + (size_t)(row0 + ai * HALF + m * 16) * ldc + col0 + bj * HALF) = (u32x2e){lo, hi}; continue; }
#endif
                    u32x4 w; w.x = cvtpk(v0[0], v0[1]); w.y = cvtpk(v0[2], v0[3]); w.z = cvtpk(v1[0], v1[1]); w.w = cvtpk(v1[2], v1[3]);
                    *(u32x4*)(rowp + bj * HALF) = w; } }
    }
};
#if GATE_U8
struct EpiMerge {
    static constexpr bool PERM = true, AFTER_DRAIN = false, HAS_MID = true;
    const bf16_t* Gr; const bf16_t* Ga; bf16_t* O;
    __device__ __forceinline__ void mid(f32x4 (&acc)[2][2][4][2], const Unit& u, int wr, int wc, int fr, int fq) const {
        int opq; asm volatile("v_mov_b32 %0, 0" : "=v"(opq));
        const int row0 = u.pm * BM + wr * 64 + fr + opq, col0 = u.pn * BM + wc * 32 + 8 * fq;
        const unsigned char* R8 = (const unsigned char*)Gr; const unsigned char* A8 = (const unsigned char*)Ga;
        u32x2e gr[2][4][2], ga[2][4][2];
#pragma unroll
        for (int ai = 0; ai < 2; ++ai)
#pragma unroll
            for (int m = 0; m < 4; ++m)
#pragma unroll
                for (int bj = 0; bj < 2; ++bj) { const size_t off = (size_t)(row0 + ai * HALF + m * 16) * 4096 + col0 + bj * HALF; gr[ai][m][bj] = *(const u32x2e*)(R8 + off); ga[ai][m][bj] = *(const u32x2e*)(A8 + off); }
        __builtin_amdgcn_sched_barrier(0);
#pragma unroll
        for (int ai = 0; ai < 2; ++ai)
#pragma unroll
            for (int m = 0; m < 4; ++m)
#pragma unroll
                for (int bj = 0; bj < 2; ++bj) { const u32x2e r = gr[ai][m][bj], a = ga[ai][m][bj]; f32x4 s0, s1;
#pragma unroll
                    for (int j = 0; j < 4; ++j) { s0[j] = ub(r.x, j) * __builtin_amdgcn_rcpf(ub(a.x, j)); s1[j] = ub(r.y, j) * __builtin_amdgcn_rcpf(ub(a.y, j)); }
                    acc[ai][bj][m][0] *= s0; acc[ai][bj][m][1] *= s1; }
        __builtin_amdgcn_sched_barrier(0);
    }
    __device__ __forceinline__ void operator()(const f32x4 (&acc)[2][2][4][2], const Unit& u, int wr, int wc, int fr, int fq) const {
        const int row0 = u.pm * BM + wr * 64 + fr, col0 = u.pn * BM + wc * 32 + 8 * fq;
        const unsigned char* A8 = (const unsigned char*)Ga;
        u32x2e ga[2][4][2];
#pragma unroll
        for (int ai = 0; ai < 2; ++ai)
#pragma unroll
            for (int m = 0; m < 4; ++m)
#pragma unroll
                for (int bj = 0; bj < 2; ++bj) ga[ai][m][bj] = *(const u32x2e*)(A8 + (size_t)(row0 + ai * HALF + m * 16) * 4096 + col0 + bj * HALF);
        __builtin_amdgcn_sched_barrier(0);
        const float k = 1.0f / 255.0f;
#pragma unroll
        for (int ai = 0; ai < 2; ++ai)
#pragma unroll
            for (int m = 0; m < 4; ++m)
#pragma unroll
                for (int bj = 0; bj < 2; ++bj) { const u32x2e g = ga[ai][m][bj]; const f32x4 v0 = acc[ai][bj][m][0] * k, v1 = acc[ai][bj][m][1] * k;
                    u32x4 w; w.x = cvtpk(v0[0] * ub(g.x, 0), v0[1] * ub(g.x, 1)); w.y = cvtpk(v0[2] * ub(g.x, 2), v0[3] * ub(g.x, 3)); w.z = cvtpk(v1[0] * ub(g.y, 0), v1[1] * ub(g.y, 1)); w.w = cvtpk(v1[2] * ub(g.y, 2), v1[3] * ub(g.y, 3));
                    *(u32x4*)(O + (size_t)(row0 + ai * HALF + m * 16) * 4096 + col0 + bj * HALF) = w; }
    }
};
#else
template <bool I8FIRST>
struct EpiMergeT {
    static constexpr bool PERM = true, AFTER_DRAIN = false, HAS_MID = true;
    const bf16_t* Gr; const bf16_t* Ga; bf16_t* O; const float* RS2 = nullptr; const float* CS2 = nullptr;
    __device__ __forceinline__ void mid(f32x4 (&acc)[2][2][4][2], const Unit& u, int wr, int wc, int fr, int fq) const {
        int opq; asm volatile("v_mov_b32 %0, 0" : "=v"(opq));
        const int row0 = u.pm * BM + wr * 64 + fr + opq, col0 = u.pn * BM + wc * 32 + 8 * fq + opq;
        if (I8FIRST) {
            f32x4 cs[2][2];
#pragma unroll
            for (int bj = 0; bj < 2; ++bj)
#pragma unroll
                for (int n = 0; n < 2; ++n) cs[bj][n] = *(const f32x4*)(CS2 + col0 + bj * HALF + 4 * n);
#pragma unroll
            for (int ai = 0; ai < 2; ++ai)
#pragma unroll
                for (int m = 0; m < 4; ++m) { const float rs = RS2[row0 + ai * HALF + m * 16];
#pragma unroll
                    for (int bj = 0; bj < 2; ++bj)
#pragma unroll
                        for (int n = 0; n < 2; ++n) { const i32x4e iv = __builtin_bit_cast(i32x4e, acc[ai][bj][m][n]);
#pragma unroll
                            for (int j = 0; j < 4; ++j) acc[ai][bj][m][n][j] = (float)iv[j] * (rs * cs[bj][n][j]);
                            asm volatile("" : "+v"(acc[ai][bj][m][n])); } }
            __builtin_amdgcn_sched_barrier(0); asm volatile("" ::: "memory");
        }
#pragma unroll
        for (int ai = 0; ai < 2; ++ai)
#pragma unroll
        for (int mh = 0; mh < 1; ++mh) {
            const int mlo = 0, mhi = 4;
            u32x4 gr[4][2], ga[4][2];
#pragma unroll
            for (int m = 0; m < 4; ++m) if (m >= mlo && m < mhi)
#pragma unroll
                for (int bj = 0; bj < 2; ++bj) { const size_t off = (size_t)(row0 + ai * HALF + m * 16) * 4096 + col0 + bj * HALF; gr[m][bj] = *(const u32x4*)(Gr + off); ga[m][bj] = *(const u32x4*)(Ga + off); }
            __builtin_amdgcn_sched_barrier(0);
#pragma unroll
            for (int m = 0; m < 4; ++m) if (m >= mlo && m < mhi)
#pragma unroll
                for (int bj = 0; bj < 2; ++bj) { const u32x4 r = gr[m][bj], a = ga[m][bj]; f32x4 s0, s1;
                    s0[0] = bflo(r.x) * __builtin_amdgcn_rcpf(bflo(a.x)); s0[1] = bfhi(r.x) * __builtin_amdgcn_rcpf(bfhi(a.x)); s0[2] = bflo(r.y) * __builtin_amdgcn_rcpf(bflo(a.y)); s0[3] = bfhi(r.y) * __builtin_amdgcn_rcpf(bfhi(a.y));
                    s1[0] = bflo(r.z) * __builtin_amdgcn_rcpf(bflo(a.z)); s1[1] = bfhi(r.z) * __builtin_amdgcn_rcpf(bfhi(a.z)); s1[2] = bflo(r.w) * __builtin_amdgcn_rcpf(bflo(a.w)); s1[3] = bfhi(r.w) * __builtin_amdgcn_rcpf(bfhi(a.w));
                    acc[ai][bj][m][0] *= s0; acc[ai][bj][m][1] *= s1; if (I8FIRST) { asm volatile("" : "+v"(acc[ai][bj][m][0])); asm volatile("" : "+v"(acc[ai][bj][m][1])); } }
            __builtin_amdgcn_sched_barrier(0); if (I8FIRST) asm volatile("" ::: "memory");
        }
    }
    __device__ __forceinline__ void operator()(const f32x4 (&acc)[2][2][4][2], const Unit& u, int wr, int wc, int fr, int fq) const {
        const int row0 = u.pm * BM + wr * 64 + fr, col0 = u.pn * BM + wc * 32 + 8 * fq;
        u32x4 ga[2][4][2];
#pragma unroll
        for (int ai = 0; ai < 2; ++ai)
#pragma unroll
            for (int m = 0; m < 4; ++m)
#pragma unroll
                for (int bj = 0; bj < 2; ++bj) ga[ai][m][bj] = *(const u32x4*)(Ga + (size_t)(row0 + ai * HALF + m * 16) * 4096 + col0 + bj * HALF);
        __builtin_amdgcn_sched_barrier(0);
#pragma unroll
        for (int ai = 0; ai < 2; ++ai)
#pragma unroll
            for (int m = 0; m < 4; ++m)
#pragma unroll
                for (int bj = 0; bj < 2; ++bj) { const u32x4 g = ga[ai][m][bj]; const f32x4 v0 = acc[ai][bj][m][0], v1 = acc[ai][bj][m][1];
                    u32x4 w; w.x = cvtpk(v0[0] * bflo(g.x), v0[1] * bfhi(g.x)); w.y = cvtpk(v0[2] * bflo(g.y), v0[3] * bfhi(g.y)); w.z = cvtpk(v1[0] * bflo(g.z), v1[1] * bfhi(g.z)); w.w = cvtpk(v1[2] * bflo(g.w), v1[3] * bfhi(g.w));
                    *(u32x4*)(O + (size_t)(row0 + ai * HALF + m * 16) * 4096 + col0 + bj * HALF) = w; }
    }
};
using EpiMerge = EpiMergeT<false>;
#endif
struct EpiOut {
    static constexpr bool PERM = true, AFTER_DRAIN = false, HAS_MID = false;
    const float* gate; bf16_t* O;
    __device__ __forceinline__ void operator()(const f32x4 (&acc)[2][2][4][2], const Unit& u, int wr, int wc, int fr, int fq) const {
        const int row0 = u.pm * BM + wr * 64 + fr, col0 = u.pn * BM + wc * 32 + 8 * fq;
        f32x4 gv[2][2];
#pragma unroll
        for (int bj = 0; bj < 2; ++bj)
#pragma unroll
            for (int n = 0; n < 2; ++n) gv[bj][n] = *(const f32x4*)(gate + col0 + bj * HALF + 4 * n);
#pragma unroll
        for (int ai = 0; ai < 2; ++ai)
#pragma unroll
            for (int m = 0; m < 4; ++m) { const size_t off = (size_t)(row0 + ai * HALF + m * 16) * 4096 + col0;
#pragma unroll
                for (int bj = 0; bj < 2; ++bj) { const f32x4 v0 = gv[bj][0] * acc[ai][bj][m][0], v1 = gv[bj][1] * acc[ai][bj][m][1];
                    u32x4 w; w.x = cvtpk(v0[0], v0[1]); w.y = cvtpk(v0[2], v0[3]); w.z = cvtpk(v1[0], v1[1]); w.w = cvtpk(v1[2], v1[3]);
                    *(u32x4*)(O + off + bj * HALF) = w; } }
    }
};

struct EpiDummy {
    static constexpr bool PERM = true, AFTER_DRAIN = false, HAS_MID = false;
    bf16_t* O;
    __device__ __forceinline__ void operator()(const f32x4 (&acc)[2][2][4][2], const Unit& u, int wr, int wc, int fr, int fq) const {
        const int row0 = u.pm * BM + wr * 64 + fr, col0 = wc * 32 + 8 * fq;
#pragma unroll
        for (int ai = 0; ai < 2; ++ai)
#pragma unroll
            for (int m = 0; m < 4; ++m) { bf16_t* rowp = O + (size_t)(row0 + ai * HALF + m * 16) * 256 + col0;
#pragma unroll
                for (int bj = 0; bj < 2; ++bj) { const f32x4 v0 = acc[ai][bj][m][0], v1 = acc[ai][bj][m][1];
                    u32x4 w; w.x = cvtpk(v0[0], v0[1]); w.y = cvtpk(v0[2], v0[3]); w.z = cvtpk(v1[0], v1[1]); w.w = cvtpk(v1[2], v1[3]);
                    *(u32x4*)(rowp + bj * HALF) = w; } }
    }
};
template <class Epi, class Sched, bool ALIGN_EPI = false, bool SP2 = false>
__device__ __forceinline__ void gemm_phase(PG8_LAS unsigned char* lds, const Gemm g, const Sched& S, const Epi& E) {
    const int tid = threadIdx.x, wid = __builtin_amdgcn_readfirstlane(tid >> 6), lane = tid & 63, wr = wid >> 2, wc = wid & 3, fr = lane & 15, fq = lane >> 4;
    const int nt = g.K / BK, K = g.ld ? g.ld : g.K;
    unsigned voffA[2], voffB[2];
#pragma unroll
    for (int i = 0; i < 2; ++i) { int R, C; stage_rc(tid * 16 + i * 8192, R, C); const int Rb = Epi::PERM ? ((R & ~31) + perm32(R & 31)) : R;
        voffA[i] = (unsigned)(R * K + C) * 2u; voffB[i] = (unsigned)(Rb * K + C) * 2u; }
    const size_t kstep = (size_t)(BK * 2);
    const size_t hstep = (size_t)HALF * K * 2;
    const size_t tstep = 2 * hstep;
    const unsigned ldsw = (unsigned)wid * 1024u;
    const int aoff = lds_byte(wr * 64 + fr, fq * 8), boff = lds_byte(wc * 32 + fr, fq * 8);
#define PG8_SA(b, h) (((b) * 2 + (h)) * HTB)
#define PG8_SB(b, h) ((4 + (b) * 2 + (h)) * HTB)
#define PG8_STAGE(bufoff, gbase, voff) do { _Pragma("unroll") for (int _i = 0; _i < 2; ++_i) \
        __builtin_amdgcn_global_load_lds((const unsigned*)((const char*)(gbase) + (voff)[_i]), (PG8_LAS unsigned*)(lds + (bufoff) + ldsw + _i * 8192), 16, 0, 0); } while (0)
#define PG8_LDA(dst, b, h) do { _Pragma("unroll") for (int m = 0; m < 4; ++m) _Pragma("unroll") for (int k = 0; k < 2; ++k) dst[m][k] = *(const PG8_LAS bf16x8*)(lds + PG8_SA(b, h) + aoff + m * 2048 + k * 1024); } while (0)
#define PG8_LDB(dst, b, h) do { _Pragma("unroll") for (int n = 0; n < 2; ++n) _Pragma("unroll") for (int k = 0; k < 2; ++k) dst[n][k] = *(const PG8_LAS bf16x8*)(lds + PG8_SB(b, h) + boff + n * 2048 + k * 1024); } while (0)
#define PG8_MMA(ai, bj, At, Bt) do { __builtin_amdgcn_s_setprio(1); _Pragma("unroll") for (int m = 0; m < 4; ++m) _Pragma("unroll") for (int n = 0; n < 2; ++n) _Pragma("unroll") for (int k = 0; k < 2; ++k) \
        acc[ai][bj][m][n] = __builtin_amdgcn_mfma_f32_16x16x32_bf16(Bt[n][k], At[m][k], acc[ai][bj][m][n], 0, 0, 0); __builtin_amdgcn_s_setprio(0); } while (0)
#define PG8_WAIT_V(n) asm volatile("s_waitcnt vmcnt(" #n ")" ::: "memory")
#define PG8_WAIT_L(n) asm volatile("s_waitcnt lgkmcnt(" #n ")" ::: "memory")
#define PG8_BAR __builtin_amdgcn_s_barrier()
#define PG8_SCHED __builtin_amdgcn_sched_barrier(0)
    Unit cur, nxt; int ui = 0;
    if (!S.next(0, cur)) return;
    f32x4 acc[2][2][4][2];
#pragma unroll
    for (int a = 0; a < 2; ++a)
#pragma unroll
        for (int b = 0; b < 2; ++b)
#pragma unroll
            for (int m = 0; m < 4; ++m)
#pragma unroll
                for (int n = 0; n < 2; ++n) acc[a][b][m][n] = (f32x4){0.f, 0.f, 0.f, 0.f};
    bf16x8 At[4][2], B0[2][2], B1[2][2];
    const char* cA = (const char*)g.A + (size_t)(cur.pm & g.amask) * tstep; const char* cB = (const char*)g.Bt + (size_t)(cur.pn & g.bmask) * tstep;
    S.a_ready(cur);
    if constexpr (SP2) {
        PG8_STAGE(PG8_SB(0, 0), cB, voffB); PG8_STAGE(PG8_SB(0, 1), cB + hstep, voffB); PG8_STAGE(PG8_SA(0, 0), cA, voffA); PG8_STAGE(PG8_SA(0, 1), cA + hstep, voffA);
        if (wr == 1) PG8_BAR;
        PG8_WAIT_V(2); PG8_BAR;
        PG8_STAGE(PG8_SB(1, 0), cB + kstep, voffB); PG8_STAGE(PG8_SA(1, 0), cA + kstep, voffA); PG8_STAGE(PG8_SB(1, 1), cB + hstep + kstep, voffB);
        PG8_WAIT_V(6); PG8_BAR;
    } else {
        PG8_STAGE(PG8_SB(0, 0), cB, voffB); PG8_STAGE(PG8_SA(0, 0), cA, voffA); PG8_STAGE(PG8_SB(0, 1), cB + hstep, voffB); PG8_STAGE(PG8_SA(0, 1), cA + hstep, voffA);
        if (wr == 1) PG8_BAR;
        PG8_WAIT_V(4); PG8_BAR;
        PG8_STAGE(PG8_SB(1, 0), cB + kstep, voffB); PG8_STAGE(PG8_SA(1, 0), cA + kstep, voffA); PG8_STAGE(PG8_SB(1, 1), cB + hstep + kstep, voffB);
        PG8_WAIT_V(6); PG8_BAR;
    }
    for (;;) {
        const bool has_next = S.next(ui + 1, nxt);
        const char* nA = has_next ? (const char*)g.A + (size_t)(nxt.pm & g.amask) * tstep : cA; const char* nB = has_next ? (const char*)g.Bt + (size_t)(nxt.pn & g.bmask) * tstep : cB;
        for (int t = 0; t < nt; t += 2) {
            const bool last = (t == nt - 2);
            const char* a1 = cA + (size_t)(t + 1) * kstep;
            const char* a2 = last ? nA : cA + (size_t)(t + 2) * kstep; const char* b2 = last ? nB : cB + (size_t)(t + 2) * kstep;
            const char* a3 = a2 + kstep; const char* b3 = b2 + kstep;
            if (last && has_next) S.a_ready(nxt);
            if constexpr (Epi::HAS_MID) { if (t == (nt >> 1)) {
                if (wr == 0) PG8_BAR; E.mid(acc, cur, wr, wc, fr, fq); if (wr == 1) PG8_BAR; } }
            if constexpr (SP2) {
            PG8_LDB(B0, 0, 0); PG8_LDB(B1, 0, 1); PG8_SCHED; PG8_LDA(At, 0, 0); PG8_STAGE(PG8_SA(1, 1), a1 + hstep, voffA);
            PG8_WAIT_V(8); PG8_WAIT_L(0); PG8_BAR; PG8_MMA(0, 0, At, B0); PG8_MMA(0, 1, At, B1); PG8_BAR; PG8_SCHED;
            PG8_LDA(At, 0, 1); PG8_STAGE(PG8_SB(0, 0), b2, voffB); PG8_STAGE(PG8_SB(0, 1), b2 + hstep, voffB); PG8_STAGE(PG8_SA(0, 0), a2, voffA);
            PG8_WAIT_V(8); PG8_WAIT_L(0); PG8_BAR; PG8_MMA(1, 0, At, B0); PG8_MMA(1, 1, At, B1); PG8_BAR; PG8_SCHED;
            PG8_LDB(B0, 1, 0); PG8_LDB(B1, 1, 1); PG8_SCHED; PG8_LDA(At, 1, 0); PG8_STAGE(PG8_SA(0, 1), a2 + hstep, voffA);
            PG8_WAIT_V(8); PG8_WAIT_L(0); PG8_BAR; PG8_MMA(0, 0, At, B0); PG8_MMA(0, 1, At, B1); PG8_BAR; PG8_SCHED;
            PG8_LDA(At, 1, 1); PG8_STAGE(PG8_SB(1, 0), b3, voffB); PG8_STAGE(PG8_SB(1, 1), b3 + hstep, voffB); PG8_STAGE(PG8_SA(1, 0), a3, voffA);
            PG8_WAIT_V(8); PG8_WAIT_L(0); PG8_BAR; PG8_MMA(1, 0, At, B0); PG8_MMA(1, 1, At, B1); PG8_BAR; PG8_SCHED;
            } else {
            PG8_LDB(B0, 0, 0); PG8_SCHED; PG8_LDA(At, 0, 0); PG8_STAGE(PG8_SA(1, 1), a1 + hstep, voffA);
            PG8_WAIT_L(8); PG8_BAR; PG8_WAIT_L(0); PG8_MMA(0, 0, At, B0); PG8_BAR; PG8_SCHED;
            PG8_LDB(B1, 0, 1); PG8_STAGE(PG8_SB(0, 0), b2, voffB);
            PG8_BAR; PG8_WAIT_L(0); PG8_MMA(0, 1, At, B1); PG8_BAR;
            PG8_LDA(At, 0, 1); PG8_STAGE(PG8_SA(0, 0), a2, voffA);
            PG8_BAR; PG8_WAIT_L(0); PG8_MMA(1, 0, At, B0); PG8_BAR; PG8_SCHED;
            PG8_STAGE(PG8_SB(0, 1), b2 + hstep, voffB);
            PG8_WAIT_V(6); PG8_BAR; PG8_MMA(1, 1, At, B1); PG8_BAR;
            PG8_LDB(B0, 1, 0); PG8_SCHED; PG8_LDA(At, 1, 0); PG8_STAGE(PG8_SA(0, 1), a2 + hstep, voffA);
            PG8_WAIT_L(8); PG8_BAR; PG8_WAIT_L(0); PG8_MMA(0, 0, At, B0); PG8_BAR; PG8_SCHED;
            PG8_LDB(B1, 1, 1); PG8_STAGE(PG8_SB(1, 0), b3, voffB);
            PG8_BAR; PG8_WAIT_L(0); PG8_MMA(0, 1, At, B1); PG8_BAR;
            PG8_LDA(At, 1, 1); PG8_STAGE(PG8_SA(1, 0), a3, voffA);
            PG8_BAR; PG8_WAIT_L(0); PG8_MMA(1, 0, At, B0); PG8_BAR; PG8_SCHED;
            PG8_STAGE(PG8_SB(1, 1), b3 + hstep, voffB);
            PG8_WAIT_V(6); PG8_BAR; PG8_MMA(1, 1, At, B1); PG8_BAR;
            }
        }
        if constexpr (ALIGN_EPI) { if (wr == 0) PG8_BAR; }
        if constexpr (!Epi::AFTER_DRAIN) { E(acc, cur, wr, wc, fr, fq); S.done(cur); }
        if (!has_next) break;
#pragma unroll
        for (int a = 0; a < 2; ++a)
#pragma unroll
            for (int b = 0; b < 2; ++b)
#pragma unroll
                for (int m = 0; m < 4; ++m)
#pragma unroll
                    for (int n = 0; n < 2; ++n) acc[a][b][m][n] = (f32x4){0.f, 0.f, 0.f, 0.f};
        cur = nxt; cA = nA; cB = nB; ++ui;
        if constexpr (ALIGN_EPI) { if (wr == 1) PG8_BAR; }
    }
    PG8_WAIT_V(0);
    if constexpr (!ALIGN_EPI) { if (wr == 0) PG8_BAR; }
    PG8_BAR;
    if constexpr (Epi::AFTER_DRAIN) { E.fused(acc, cur, wr, wc, fr, fq, lds, wid, lane); S.done(cur); }
#undef PG8_SA
#undef PG8_SB
#undef PG8_STAGE
#undef PG8_LDA
#undef PG8_LDB
#undef PG8_MMA
#undef PG8_WAIT_V
#undef PG8_WAIT_L
#undef PG8_BAR
#undef PG8_SCHED
}
typedef int i32x4v __attribute__((ext_vector_type(4)));
typedef int i32x8v __attribute__((ext_vector_type(8)));
__device__ __forceinline__ bf16x8 bfl8(const i32x8v& v) { const i32x4v t = __builtin_shufflevector(v, v, 0, 1, 2, 3); return __builtin_bit_cast(bf16x8, t); }
__device__ __forceinline__ bf16x8 bfh8(const i32x8v& v) { const i32x4v t = __builtin_shufflevector(v, v, 4, 5, 6, 7); return __builtin_bit_cast(bf16x8, t); }
__device__ __forceinline__ i32x4v i4l8(const i32x8v& v) { return __builtin_shufflevector(v, v, 0, 1, 2, 3); }
__device__ __forceinline__ i32x4v i4h8(const i32x8v& v) { return __builtin_shufflevector(v, v, 4, 5, 6, 7); }
__device__ __forceinline__ i32x8v cat8(const bf16x8& lo, const bf16x8& hi) { return __builtin_shufflevector(__builtin_bit_cast(i32x4v, lo), __builtin_bit_cast(i32x4v, hi), 0, 1, 2, 3, 4, 5, 6, 7); }
template <class Epi, class Sched, bool I8 = false>
__device__ __forceinline__ void gemm_phase_mixed(PG8_LAS unsigned char* lds, const Gemm g, const Sched& S, const Epi& E) {
    const int tid = threadIdx.x, wid = __builtin_amdgcn_readfirstlane(tid >> 6), lane = tid & 63, wr = wid >> 2, wc = wid & 3, fr = lane & 15, fq = lane >> 4;
    const int nt = g.K / BK, K = g.K;
    unsigned voffA[2], voffB[2];
#pragma unroll
    for (int i = 0; i < 2; ++i) { int R, C; stage_rc(tid * 16 + i * 8192, R, C); const int Rb = Epi::PERM ? ((R & ~31) + perm32(R & 31)) : R;
        voffA[i] = (unsigned)(R * K + C) * 2u; voffB[i] = (unsigned)(Rb * K + C) * 2u; }
    const size_t kstep = (size_t)(BK * 2);
    const size_t hstep = (size_t)HALF * K * 2;
    const size_t tstep = 2 * hstep;
    const unsigned ldsw = (unsigned)wid * 1024u;
    const int aoff = lds_byte(wr * 64 + fr, fq * 8), boff = lds_byte(wc * 32 + fr, fq * 8);
    const int sc1 = 0x7f7f7f7f;
#define PG8_SA(b, h) (((b) * 2 + (h)) * HTB)
#define PG8_SB(b, h) ((4 + (b) * 2 + (h)) * HTB)
#define PG8_STAGE(bufoff, gbase, voff) do { _Pragma("unroll") for (int _i = 0; _i < 2; ++_i) \
        __builtin_amdgcn_global_load_lds((const unsigned*)((const char*)(gbase) + (voff)[_i]), (PG8_LAS unsigned*)(lds + (bufoff) + ldsw + _i * 8192), 16, 0, 0); } while (0)
#define PG8_LDA(dst, b, h) do { _Pragma("unroll") for (int m = 0; m < 4; ++m) { dst[m].lo = *(const PG8_LAS i32x4v*)(lds + PG8_SA(b, h) + aoff + m * 2048); dst[m].hi = *(const PG8_LAS i32x4v*)(lds + PG8_SA(b, h) + aoff + m * 2048 + 1024); } } while (0)
#define PG8_LDB(dst, b, h) do { _Pragma("unroll") for (int n = 0; n < 2; ++n) { dst[n].lo = *(const PG8_LAS i32x4v*)(lds + PG8_SB(b, h) + boff + n * 2048); dst[n].hi = *(const PG8_LAS i32x4v*)(lds + PG8_SB(b, h) + boff + n * 2048 + 1024); } } while (0)
#define PG8_MMA16(ai, bj, At, Bt) do { __builtin_amdgcn_s_setprio(1); _Pragma("unroll") for (int m = 0; m < 4; ++m) _Pragma("unroll") for (int n = 0; n < 2; ++n) { \
            acc[ai][bj][m][n] = __builtin_amdgcn_mfma_f32_16x16x32_bf16(bfl8(Bt[n]), bfl8(At[m]), acc[ai][bj][m][n], 0, 0, 0); \
            acc[ai][bj][m][n] = __builtin_amdgcn_mfma_f32_16x16x32_bf16(bfh8(Bt[n]), bfh8(At[m]), acc[ai][bj][m][n], 0, 0, 0); } \
        __builtin_amdgcn_s_setprio(0); } while (0)
#define PG8_MMA8(ai, bj, At, Bt) do { __builtin_amdgcn_s_setprio(1); _Pragma("unroll") for (int m = 0; m < 4; ++m) _Pragma("unroll") for (int n = 0; n < 2; ++n) \
            asm volatile("v_mfma_scale_f32_16x16x128_f8f6f4 %0, %1, %2, %0, %3, %3 op_sel_hi:[0,0,0]" : "+v"(acc[ai][bj][m][n]) : "v"(Bt[n]), "v"(At[m]), "v"(sc1)); \
        __builtin_amdgcn_s_setprio(0); } while (0)
#define PG8_MMAI8(ai, bj, At, Bt) do { __builtin_amdgcn_s_setprio(1); _Pragma("unroll") for (int m = 0; m < 4; ++m) _Pragma("unroll") for (int n = 0; n < 2; ++n) { \
            acc[ai][bj][m][n] = __builtin_bit_cast(f32x4, __builtin_amdgcn_mfma_i32_16x16x64_i8(i4l8(Bt[n]), i4l8(At[m]), __builtin_bit_cast(i32x4v, acc[ai][bj][m][n]), 0, 0, 0)); \
            acc[ai][bj][m][n] = __builtin_bit_cast(f32x4, __builtin_amdgcn_mfma_i32_16x16x64_i8(i4h8(Bt[n]), i4h8(At[m]), __builtin_bit_cast(i32x4v, acc[ai][bj][m][n]), 0, 0, 0)); } \
        __builtin_amdgcn_s_setprio(0); } while (0)
#define PG8_WAIT_V(n) asm volatile("s_waitcnt vmcnt(" #n ")" ::: "memory")
#define PG8_WAIT_L(n) asm volatile("s_waitcnt lgkmcnt(" #n ")" ::: "memory")
#define PG8_BAR __builtin_amdgcn_s_barrier()
#define PG8_SCHED __builtin_amdgcn_sched_barrier(0)
#define PG8_UNIT(u, f8_, pA_, pB_) do { const int sl_ = f8_slot((u).pn, g.f8_mask); f8_ = sl_ >= 0; \
        pA_ = (f8_ ? (const char*)g.A8 : (const char*)g.A) + (size_t)(u).pm * tstep; \
        pB_ = f8_ ? (const char*)g.B8 + (size_t)sl_ * tstep : (const char*)g.Bt + (size_t)(u).pn * tstep; } while (0)
#define PG8_KLOOP(ntu, MMA_) do { \
        for (int t = 0; t < (ntu); t += 2) { \
            const bool last = (t == (ntu) - 2); \
            const char* a1 = cA + (size_t)(t + 1) * kstep; \
            const char* a2 = last ? nA : cA + (size_t)(t + 2) * kstep; const char* b2 = last ? nB : cB + (size_t)(t + 2) * kstep; \
            const char* a3 = a2 + kstep; const char* b3 = b2 + kstep; \
            PG8_LDB(B0, 0, 0); PG8_LDB(B1, 0, 1); PG8_SCHED; PG8_LDA(At, 0, 0); PG8_STAGE(PG8_SA(1, 1), a1 + hstep, voffA); \
            PG8_WAIT_V(8); PG8_WAIT_L(0); PG8_BAR; MMA_(0, 0, At, B0); MMA_(0, 1, At, B1); PG8_BAR; PG8_SCHED; \
            PG8_LDA(At, 0, 1); PG8_STAGE(PG8_SB(0, 0), b2, voffB); PG8_STAGE(PG8_SB(0, 1), b2 + hstep, voffB); PG8_STAGE(PG8_SA(0, 0), a2, voffA); \
            PG8_WAIT_V(8); PG8_WAIT_L(0); PG8_BAR; MMA_(1, 0, At, B0); MMA_(1, 1, At, B1); PG8_BAR; PG8_SCHED; \
            PG8_LDB(B0, 1, 0); PG8_LDB(B1, 1, 1); PG8_SCHED; PG8_LDA(At, 1, 0); PG8_STAGE(PG8_SA(0, 1), a2 + hstep, voffA); \
            PG8_WAIT_V(8); PG8_WAIT_L(0); PG8_BAR; MMA_(0, 0, At, B0); MMA_(0, 1, At, B1); PG8_BAR; PG8_SCHED; \
            PG8_LDA(At, 1, 1); PG8_STAGE(PG8_SB(1, 0), b3, voffB); PG8_STAGE(PG8_SB(1, 1), b3 + hstep, voffB); PG8_STAGE(PG8_SA(1, 0), a3, voffA); \
            PG8_WAIT_V(8); PG8_WAIT_L(0); PG8_BAR; MMA_(1, 0, At, B0); MMA_(1, 1, At, B1); PG8_BAR; PG8_SCHED; \
        } } while (0)
    Unit cur, nxt; int ui = 0;
    if (!S.next(0, cur)) return;
    f32x4 acc[2][2][4][2];
#pragma unroll
    for (int a = 0; a < 2; ++a)
#pragma unroll
        for (int b = 0; b < 2; ++b)
#pragma unroll
            for (int m = 0; m < 4; ++m)
#pragma unroll
                for (int n = 0; n < 2; ++n) acc[a][b][m][n] = (f32x4){0.f, 0.f, 0.f, 0.f};
    i32x8v At[4], B0[2], B1[2];
    bool f8c, f8n = false; const char *cA, *cB, *nA, *nB;
    PG8_UNIT(cur, f8c, cA, cB);
    S.a_ready(cur);
    PG8_STAGE(PG8_SB(0, 0), cB, voffB); PG8_STAGE(PG8_SB(0, 1), cB + hstep, voffB); PG8_STAGE(PG8_SA(0, 0), cA, voffA); PG8_STAGE(PG8_SA(0, 1), cA + hstep, voffA);
    if (wr == 1) PG8_BAR;
    PG8_WAIT_V(2); PG8_BAR;
    PG8_STAGE(PG8_SB(1, 0), cB + kstep, voffB); PG8_STAGE(PG8_SA(1, 0), cA + kstep, voffA); PG8_STAGE(PG8_SB(1, 1), cB + hstep + kstep, voffB);
    PG8_WAIT_V(6); PG8_BAR;
    for (;;) {
        const bool has_next = S.next(ui + 1, nxt);
        if (has_next) { PG8_UNIT(nxt, f8n, nA, nB); } else { nA = cA; nB = cB; }
        if (f8c) { if constexpr (I8) { PG8_KLOOP(nt >> 1, PG8_MMAI8); } else { PG8_KLOOP(nt >> 1, PG8_MMA8); asm volatile("s_nop 15\n\ts_nop 15" ::: "memory"); } }
        else PG8_KLOOP(nt, PG8_MMA16);
        if (wr == 0) PG8_BAR;
        E(acc, cur, wr, wc, fr, fq); S.done(cur);
        if (!has_next) break;
#pragma unroll
        for (int a = 0; a < 2; ++a)
#pragma unroll
            for (int b = 0; b < 2; ++b)
#pragma unroll
                for (int m = 0; m < 4; ++m)
#pragma unroll
                    for (int n = 0; n < 2; ++n) acc[a][b][m][n] = (f32x4){0.f, 0.f, 0.f, 0.f};
        cur = nxt; cA = nA; cB = nB; f8c = f8n; ++ui;
        if (wr == 1) PG8_BAR;
    }
    PG8_WAIT_V(0);
    PG8_BAR;
#undef PG8_UNIT
#undef PG8_KLOOP
#undef PG8_SA
#undef PG8_SB
#undef PG8_STAGE
#undef PG8_LDA
#undef PG8_LDB
#undef PG8_MMA16
#undef PG8_MMA8
#undef PG8_MMAI8
#undef PG8_WAIT_V
#undef PG8_WAIT_L
#undef PG8_BAR
#undef PG8_SCHED
}
template <class Epi, class Sched>
__device__ __forceinline__ void gemm_phase_split(PG8_LAS unsigned char* lds, const Gemm g, const Sched& S, const Epi& E, const int ki, const int kb, const size_t off8) {
    const int tid = threadIdx.x, wid = __builtin_amdgcn_readfirstlane(tid >> 6), lane = tid & 63, wr = wid >> 2, wc = wid & 3, fr = lane & 15, fq = lane >> 4;
    const int nt = g.K / BK, K = g.K;
    unsigned voffA[2], voffB[2];
#pragma unroll
    for (int i = 0; i < 2; ++i) { int R, C; stage_rc(tid * 16 + i * 8192, R, C); const int Rb = Epi::PERM ? ((R & ~31) + perm32(R & 31)) : R;
        voffA[i] = (unsigned)(R * K + C) * 2u; voffB[i] = (unsigned)(Rb * K + C) * 2u; }
    const size_t kstep = (size_t)(BK * 2);
    const size_t hstep = (size_t)HALF * K * 2;
    const size_t tstep = 2 * hstep;
    const unsigned ldsw = (unsigned)wid * 1024u;
    const int aoff = lds_byte(wr * 64 + fr, fq * 8), boff = lds_byte(wc * 32 + fr, fq * 8);
    const int sc1 = 0x7f7f7f7f;
#define PG8_SA(b, h) (((b) * 2 + (h)) * HTB)
#define PG8_SB(b, h) ((4 + (b) * 2 + (h)) * HTB)
#define PG8_STAGE(bufoff, gbase, voff) do { _Pragma("unroll") for (int _i = 0; _i < 2; ++_i) \
        __builtin_amdgcn_global_load_lds((const unsigned*)((const char*)(gbase) + (voff)[_i]), (PG8_LAS unsigned*)(lds + (bufoff) + ldsw + _i * 8192), 16, 0, 0); } while (0)
#define PG8_LDA(dst, b, h) do { _Pragma("unroll") for (int m = 0; m < 4; ++m) { dst[m].lo = *(const PG8_LAS i32x4v*)(lds + PG8_SA(b, h) + aoff + m * 2048); dst[m].hi = *(const PG8_LAS i32x4v*)(lds + PG8_SA(b, h) + aoff + m * 2048 + 1024); } } while (0)
#define PG8_LDB(dst, b, h) do { _Pragma("unroll") for (int n = 0; n < 2; ++n) { dst[n].lo = *(const PG8_LAS i32x4v*)(lds + PG8_SB(b, h) + boff + n * 2048); dst[n].hi = *(const PG8_LAS i32x4v*)(lds + PG8_SB(b, h) + boff + n * 2048 + 1024); } } while (0)
#define PG8_MMA16(ai, bj, At, Bt) do { __builtin_amdgcn_s_setprio(1); _Pragma("unroll") for (int m = 0; m < 4; ++m) _Pragma("unroll") for (int n = 0; n < 2; ++n) { \
            acc[ai][bj][m][n] = __builtin_amdgcn_mfma_f32_16x16x32_bf16(bfl8(Bt[n]), bfl8(At[m]), acc[ai][bj][m][n], 0, 0, 0); \
            acc[ai][bj][m][n] = __builtin_amdgcn_mfma_f32_16x16x32_bf16(bfh8(Bt[n]), bfh8(At[m]), acc[ai][bj][m][n], 0, 0, 0); } \
        __builtin_amdgcn_s_setprio(0); } while (0)
#define PG8_MMA8(ai, bj, At, Bt) do { __builtin_amdgcn_s_setprio(1); _Pragma("unroll") for (int m = 0; m < 4; ++m) _Pragma("unroll") for (int n = 0; n < 2; ++n) \
            asm volatile("v_mfma_scale_f32_16x16x128_f8f6f4 %0, %1, %2, %0, %3, %3 op_sel_hi:[0,0,0]" : "+v"(acc[ai][bj][m][n]) : "v"(Bt[n]), "v"(At[m]), "v"(sc1)); \
        __builtin_amdgcn_s_setprio(0); } while (0)
#define PG8_MMAI8(ai, bj, At, Bt) do { __builtin_amdgcn_s_setprio(1); _Pragma("unroll") for (int m = 0; m < 4; ++m) _Pragma("unroll") for (int n = 0; n < 2; ++n) { \
            acc[ai][bj][m][n] = __builtin_bit_cast(f32x4, __builtin_amdgcn_mfma_i32_16x16x64_i8(i4l8(Bt[n]), i4l8(At[m]), __builtin_bit_cast(i32x4v, acc[ai][bj][m][n]), 0, 0, 0)); \
            acc[ai][bj][m][n] = __builtin_bit_cast(f32x4, __builtin_amdgcn_mfma_i32_16x16x64_i8(i4h8(Bt[n]), i4h8(At[m]), __builtin_bit_cast(i32x4v, acc[ai][bj][m][n]), 0, 0, 0)); } \
        __builtin_amdgcn_s_setprio(0); } while (0)
#define PG8_WAIT_V(n) asm volatile("s_waitcnt vmcnt(" #n ")" ::: "memory")
#define PG8_WAIT_L(n) asm volatile("s_waitcnt lgkmcnt(" #n ")" ::: "memory")
#define PG8_BAR __builtin_amdgcn_s_barrier()
#define PG8_SCHED __builtin_amdgcn_sched_barrier(0)
#define PG8_UNIT(u, f8_, pA_, pB_) do { const int sl_ = f8_slot((u).pn, g.f8_mask); f8_ = sl_ >= 0; \
        pA_ = (f8_ ? (const char*)g.A8 : (const char*)g.A) + (size_t)(u).pm * tstep; \
        pB_ = f8_ ? (const char*)g.B8 + (size_t)sl_ * tstep : (const char*)g.Bt + (size_t)(u).pn * tstep; } while (0)
#define PG8_KLOOP(ntu, MMA_) do { \
        for (int t = 0; t < (ntu); t += 2) { \
            const bool last = (t == (ntu) - 2); \
            const char* a1 = cA + (size_t)(t + 1) * kstep; \
            const char* a2 = last ? nA : cA + (size_t)(t + 2) * kstep; const char* b2 = last ? nB : cB + (size_t)(t + 2) * kstep; \
            const char* a3 = a2 + kstep; const char* b3 = b2 + kstep; \
            PG8_LDB(B0, 0, 0); PG8_LDB(B1, 0, 1); PG8_SCHED; PG8_LDA(At, 0, 0); PG8_STAGE(PG8_SA(1, 1), a1 + hstep, voffA); \
            PG8_WAIT_V(8); PG8_WAIT_L(0); PG8_BAR; MMA_(0, 0, At, B0); MMA_(0, 1, At, B1); PG8_BAR; PG8_SCHED; \
            PG8_LDA(At, 0, 1); PG8_STAGE(PG8_SB(0, 0), b2, voffB); PG8_STAGE(PG8_SB(0, 1), b2 + hstep, voffB); PG8_STAGE(PG8_SA(0, 0), a2, voffA); \
            PG8_WAIT_V(8); PG8_WAIT_L(0); PG8_BAR; MMA_(1, 0, At, B0); MMA_(1, 1, At, B1); PG8_BAR; PG8_SCHED; \
            PG8_LDB(B0, 1, 0); PG8_LDB(B1, 1, 1); PG8_SCHED; PG8_LDA(At, 1, 0); PG8_STAGE(PG8_SA(0, 1), a2 + hstep, voffA); \
            PG8_WAIT_V(8); PG8_WAIT_L(0); PG8_BAR; MMA_(0, 0, At, B0); MMA_(0, 1, At, B1); PG8_BAR; PG8_SCHED; \
            PG8_LDA(At, 1, 1); PG8_STAGE(PG8_SB(1, 0), b3, voffB); PG8_STAGE(PG8_SB(1, 1), b3 + hstep, voffB); PG8_STAGE(PG8_SA(1, 0), a3, voffA); \
            PG8_WAIT_V(8); PG8_WAIT_L(0); PG8_BAR; MMA_(1, 0, At, B0); MMA_(1, 1, At, B1); PG8_BAR; PG8_SCHED; \
        } } while (0)
    Unit cur, nxt; int ui = 0;
    if (!S.next(0, cur)) return;
    f32x4 acc[2][2][4][2];
#pragma unroll
    for (int a = 0; a < 2; ++a)
#pragma unroll
        for (int b = 0; b < 2; ++b)
#pragma unroll
            for (int m = 0; m < 4; ++m)
#pragma unroll
                for (int n = 0; n < 2; ++n) acc[a][b][m][n] = (f32x4){0.f, 0.f, 0.f, 0.f};
    i32x8v At[4], B0[2], B1[2];
    const char *uA = (const char*)g.A + (size_t)cur.pm * tstep, *uB = (const char*)g.Bt + (size_t)cur.pn * tstep;
    const char *cA = uA + off8, *cB = uB + off8, *nA, *nB;
    S.a_ready(cur);
    PG8_STAGE(PG8_SB(0, 0), cB, voffB); PG8_STAGE(PG8_SB(0, 1), cB + hstep, voffB); PG8_STAGE(PG8_SA(0, 0), cA, voffA); PG8_STAGE(PG8_SA(0, 1), cA + hstep, voffA);
    if (wr == 1) PG8_BAR;
    PG8_WAIT_V(2); PG8_BAR;
    PG8_STAGE(PG8_SB(1, 0), cB + kstep, voffB); PG8_STAGE(PG8_SA(1, 0), cA + kstep, voffA); PG8_STAGE(PG8_SB(1, 1), cB + hstep + kstep, voffB);
    PG8_WAIT_V(6); PG8_BAR;
    for (;;) {
        const bool has_next = S.next(ui + 1, nxt);
        cA = uA + off8; cB = uB + off8; nA = uA; nB = uB;
        PG8_KLOOP(ki, PG8_MMAI8);
        if (wr == 0) PG8_BAR; E.mid(acc, cur, wr, wc, fr, fq); if (wr == 1) PG8_BAR;
        const char *vA = uA, *vB = uB;
        if (has_next) { vA = (const char*)g.A + (size_t)nxt.pm * tstep; vB = (const char*)g.Bt + (size_t)nxt.pn * tstep; }
        cA = uA; cB = uB; nA = vA + off8; nB = vB + off8;
        PG8_KLOOP(kb, PG8_MMA16);
        if (wr == 0) PG8_BAR;
        E(acc, cur, wr, wc, fr, fq); S.done(cur);
        if (!has_next) break;
#pragma unroll
        for (int a = 0; a < 2; ++a)
#pragma unroll
            for (int b = 0; b < 2; ++b)
#pragma unroll
                for (int m = 0; m < 4; ++m)
#pragma unroll
                    for (int n = 0; n < 2; ++n) acc[a][b][m][n] = (f32x4){0.f, 0.f, 0.f, 0.f};
        cur = nxt; uA = vA; uB = vB; ++ui;
        if (wr == 1) PG8_BAR;
    }
    PG8_WAIT_V(0);
    PG8_BAR;
#undef PG8_UNIT
#undef PG8_KLOOP
#undef PG8_SA
#undef PG8_SB
#undef PG8_STAGE
#undef PG8_LDA
#undef PG8_LDB
#undef PG8_MMA16
#undef PG8_MMA8
#undef PG8_MMAI8
#undef PG8_WAIT_V
#undef PG8_WAIT_L
#undef PG8_BAR
#undef PG8_SCHED
}
}


constexpr int NWAVES = 8;
constexpr int SEQ = 16384, DM = 4096, DIN = 25600, NQH = 64, NKVH = 8, HD = 64, DKV = 512, NCB = 16, CBW = 256;
constexpr float EPS = 1e-6f;
constexpr float LOG2E = 1.4426950408889634f;
constexpr float QSCALE = 0.125f * LOG2E;
#ifndef MK_N_LAUNCHES
#define MK_N_LAUNCHES 1
#endif
constexpr int N_PHASES = 8;
constexpr int N_LAUNCHES = MK_N_LAUNCHES;

constexpr size_t MiB = 1u << 20;
constexpr size_t WS_CTL = 0, CTL_ZERO_BYTES = 1 * MiB;
constexpr size_t WS_AGG = 6 * MiB;
#if defined(SCAN_AT16) || defined(SCAN_DMA) || defined(SCAN_STORED) || defined(SCAN_NAIVE)
#define GATE_PRESCALE 0
#else
#define GATE_PRESCALE 1
#endif
constexpr float GATE_WMUL = GATE_PRESCALE ? -LOG2E : 1.0f;
constexpr size_t WS_WGA = 2 * MiB, WS_WGX = 4 * MiB;
constexpr size_t WS_WIN = 8 * MiB;
constexpr size_t WS_WCAT = 208 * MiB, WS_WOUT = 272 * MiB;
constexpr size_t WS_H = 304 * MiB;
constexpr size_t WS_U = 432 * MiB, WS_G = 560 * MiB;
constexpr size_t WS_Q = 688 * MiB;
constexpr size_t WS_K = 816 * MiB, WS_V = 832 * MiB;
constexpr size_t WS_GA = 848 * MiB, WS_MR = 976 * MiB, WS_MA = 1104 * MiB;
constexpr size_t WS_LA = WS_WIN, WS_BB = WS_H;
#ifndef UC_PAD
#define UC_PAD 0
#endif
constexpr int UCP = DM + UC_PAD;
constexpr size_t WS_UC = WS_WIN;
constexpr size_t WS_MRG = WS_H;
constexpr size_t WS_Y2 = 1232 * MiB;
constexpr size_t WS_GO = 432 * MiB;
#ifndef F8Q
#define F8Q 1
#endif
#ifndef I8Q
#define I8Q 1
#endif
constexpr int CW_RS = 131072, CW_CS = 147456, CW_BIAS = 180224;
#ifndef I8A
#define I8A 1
#endif
constexpr int CW_RS2 = 212992, CW_CS2 = 229376;
constexpr float WQ8_SCALE = 64.0f;
constexpr size_t WS_H8 = WS_Y2;
#ifndef F8_SEGS
#define F8_SEGS ((1u << 1) | (1u << 2) | (1u << 3) | (1u << 4) | (1u << 6))
#endif
#ifndef F8_NG
#define F8_NG 0
#endif
#ifndef F8_NU
#define F8_NU 16
#endif
#ifndef F8_NMR
#define F8_NMR 16
#endif
#ifndef F8_MASK
#define F8_MASK ((F8_NG ? ((unsigned)F8_NG << 18) : 0u) | F8_SEGS | (F8_NMR ? ((1u << 5) | ((unsigned)F8_NMR << 8)) : 0u) | (F8_NU ? (1u | ((unsigned)F8_NU << 13)) : 0u))
#endif
constexpr bool ALL_LOWP = (F8Q == 1) && (I8Q != 0) && pg8::f8_count(F8_MASK) == 100;
constexpr size_t WS_WQ8 = WS_Y2 + 128 * MiB;
constexpr size_t WS_END = WS_WQ8 + 200 * MiB;
constexpr int CW_TMO = 0, CW_CODE = 1;
constexpr int CW_BAR = 4096;
constexpr int CW_MOD = 65536;

constexpr int RING_OFF = 0, RING_BYTES = 131072;
constexpr int LDSCTL_OFF = RING_BYTES, MISC_OFF = LDSCTL_OFF + 320;
constexpr int LDS_BYTES = 147456;

#define GAS __attribute__((address_space(1)))
#define LAS __attribute__((address_space(3)))
typedef unsigned short bf16;
typedef unsigned v4u __attribute__((ext_vector_type(4)));
typedef float f32x4 __attribute__((ext_vector_type(4)));
typedef short bf16x8 __attribute__((ext_vector_type(8)));
typedef GAS unsigned gu32;
typedef GAS unsigned long long gu64;
#define RLX_AGENT __ATOMIC_RELAXED, __HIP_MEMORY_SCOPE_AGENT
#define LDS_WAIT() asm volatile("s_waitcnt lgkmcnt(0)" ::: "memory")
#define VM_WAIT() asm volatile("s_waitcnt vmcnt(0)" ::: "memory")
__device__ __forceinline__ unsigned long long rt() { return __builtin_amdgcn_s_memrealtime(); }
__device__ __forceinline__ unsigned f2bf(float f) { unsigned u = __builtin_bit_cast(unsigned, f); return (u + 0x7fffu + ((u >> 16) & 1u)) >> 16; }
__device__ __forceinline__ unsigned pk2(float lo, float hi) { return f2bf(lo) | (f2bf(hi) << 16); }

#define XB_TMO      128
#define XB_XCNT(j)  (256  + 64 * (j))
#define XB_XSUB(j)  (1280 + 64 * (j))
#define XB_XGEN(j)  (2304 + 64 * (j))
#define XB_TOP      3328
#define XB_TOPGEN   3392
#define XCD_BAR_WORDS 3456
#define XB_SPIN_CAP (1u << 18)

__device__ __forceinline__ unsigned xb_ld(unsigned* p)              { return __hip_atomic_load(p, __ATOMIC_RELAXED, __HIP_MEMORY_SCOPE_AGENT); }
__device__ __forceinline__ unsigned xb_add(unsigned* p, unsigned v) { return __hip_atomic_fetch_add(p, v, __ATOMIC_RELAXED, __HIP_MEMORY_SCOPE_AGENT); }
__device__ __forceinline__ unsigned xb_xcc_id() { return (unsigned)__builtin_amdgcn_s_getreg((3 << 11) | 20) & 0xFu; }
#define XB_SPIN(cond, bar) do { unsigned _sp = 0; while (cond) { __builtin_amdgcn_s_sleep(1); \
    if ((++_sp & 255u) == 0u) { if (xb_ld(&(bar)[XB_TMO])) break; if (_sp > XB_SPIN_CAP) { atomicAdd(&(bar)[XB_TMO], 1u); break; } } } } while (0)

struct XcdBarrier {
    unsigned* bar; unsigned x;
    volatile LAS unsigned* st;
};

__device__ __forceinline__ XcdBarrier xcd_barrier_post(unsigned* bar, volatile LAS unsigned* st) {
    XcdBarrier b; b.bar = bar; b.x = xb_xcc_id(); b.st = st;
    if (threadIdx.x == 0) (void)xb_add(&bar[XB_XCNT(b.x)], 1u);
    return b;
}
__device__ __forceinline__ void xcd_barrier_complete(unsigned* bar, unsigned x, unsigned& nloc, unsigned& nx) {
    const unsigned G = gridDim.x * gridDim.y * gridDim.z;
    unsigned sum, cnt, mine, sp = 0u;
    for (;;) {
        sum = 0u; cnt = 0u; mine = 0u;
#pragma unroll
        for (unsigned j = 0; j < 16; ++j) { const unsigned c = xb_ld(&bar[XB_XCNT(j)]); sum += c; cnt += (c > 0u) ? 1u : 0u; mine = (j == x) ? c : mine; }
        if (sum == G) break;
        __builtin_amdgcn_s_sleep(1);
        if ((++sp & 255u) == 0u) { if (xb_ld(&bar[XB_TMO])) break; if (sp > XB_SPIN_CAP) { atomicAdd(&bar[XB_TMO], 1u); break; } }
    }
    nloc = mine > 0u ? mine : 1u; nx = cnt > 0u ? cnt : 1u;
}

__device__ __forceinline__ void xcd_barrier(const XcdBarrier& b) {
    asm volatile("s_waitcnt vmcnt(0)" ::: "memory");
    __syncthreads();
    if (threadIdx.x == 0) {
        unsigned* bar = b.bar;
        __builtin_amdgcn_s_waitcnt(0);
        unsigned nloc = b.st[0], nx = b.st[1];
        if (nloc == 0u) { xcd_barrier_complete(bar, b.x, nloc, nx); b.st[0] = nloc; b.st[1] = nx; }
        const unsigned old = xb_add(&bar[XB_XSUB(b.x)], 1u);
        const unsigned gen = old / nloc;
        if (old + 1u == (gen + 1u) * nloc) {
            __builtin_amdgcn_fence(__ATOMIC_RELEASE, "agent");
            asm volatile("s_waitcnt vmcnt(0)" ::: "memory");
            const unsigned og = xb_add(&bar[XB_TOP], 1u);
            const unsigned tg = og / nx;
            if (og + 1u == (tg + 1u) * nx) xb_add(&bar[XB_TOPGEN], 1u);
            else XB_SPIN(xb_ld(&bar[XB_TOPGEN]) == tg, bar);
            __builtin_amdgcn_fence(__ATOMIC_ACQUIRE, "agent");
            xb_add(&bar[XB_XGEN(b.x)], 1u);
            asm volatile("s_waitcnt vmcnt(0)" ::: "memory");
        } else {
            XB_SPIN(xb_ld(&bar[XB_XGEN(b.x)]) == gen, bar);
            __builtin_amdgcn_fence(__ATOMIC_ACQUIRE, "agent");
            asm volatile("s_waitcnt vmcnt(0)" ::: "memory");
        }
    }
    __syncthreads();
}

typedef unsigned v2u __attribute__((ext_vector_type(2)));
typedef float f32x16 __attribute__((ext_vector_type(16)));
typedef short s16x4 __attribute__((ext_vector_type(4)));
struct Args { const float* in[18]; float* out; unsigned char* ws; int ph_lo, ph_hi; };
struct Frame {
    LAS unsigned char* lds;
    volatile LAS unsigned* MISC;
    gu32* ctl;
    int tid, lane, wave, vcu, G;
};
__device__ __forceinline__ float wave_sum(float v) {
#pragma unroll
    for (int o = 1; o < 64; o <<= 1) v += __shfl_xor(v, o);
    return v;
}
__device__ __forceinline__ float wave_max(float v) {
#pragma unroll
    for (int o = 1; o < 64; o <<= 1) v = fmaxf(v, __shfl_xor(v, o));
    return v;
}
__device__ __forceinline__ unsigned pk4_i8(float a, float b, float c, float d) {
    const float M = 12582912.0f;
    const unsigned ua = __builtin_bit_cast(unsigned, a + M), ub = __builtin_bit_cast(unsigned, b + M), uc = __builtin_bit_cast(unsigned, c + M), ud = __builtin_bit_cast(unsigned, d + M);
    return __builtin_amdgcn_perm(ub, ua, 0x0c0c0400u) | __builtin_amdgcn_perm(ud, uc, 0x04000c0cu);
}
using pg8::cvtpk; using pg8::bflo; using pg8::bfhi; using pg8::sigmoid_f;

__device__ __forceinline__ unsigned pk4_fp8(float a, float b, float c, float d) { unsigned w = 0u; w = __builtin_amdgcn_cvt_pk_fp8_f32(a, b, w, false); w = __builtin_amdgcn_cvt_pk_fp8_f32(c, d, w, true); return w; }
__device__ __forceinline__ void p0_transpose_item(const float* W, int K, int N, bf16* WT, LAS float* scr, int item, int lane, int ldo = 0, unsigned char* WT8 = nullptr, unsigned f8mask = 0u, float f8scale = 1.0f, float wmul = 1.0f) {
    const int nblk = N / 32, kb = item / nblk, nb = item % nblk, k0 = 64 * kb, n0 = 32 * nb;
    float wv[32];
#pragma unroll
    for (int i = 0; i < 32; ++i) wv[i] = __builtin_nontemporal_load(&W[(size_t)(k0 + 2 * i + (lane >> 5)) * N + n0 + (lane & 31)]);
#pragma unroll
    for (int i = 0; i < 32; ++i) scr[(2 * i + (lane >> 5)) * 33 + (lane & 31)] = wv[i] * wmul;
    LDS_WAIT(); asm volatile("" ::: "memory");
    const int c = lane & 7;
    const int sl8 = WT8 != nullptr ? pg8::f8_slot(n0 >> 8, f8mask) : -1;
    if (sl8 >= 0) {
        const int r8 = sl8 * 256 + (n0 & 255);
#pragma unroll
        for (int j = 0; j < 4; ++j) { const int n = (lane >> 3) + 8 * j; const LAS float* s = scr + (8 * c) * 33 + n;
            v2u o; o.x = pk4_fp8(s[0 * 33] * f8scale, s[1 * 33] * f8scale, s[2 * 33] * f8scale, s[3 * 33] * f8scale); o.y = pk4_fp8(s[4 * 33] * f8scale, s[5 * 33] * f8scale, s[6 * 33] * f8scale, s[7 * 33] * f8scale);
            *(GAS v2u*)(WT8 + (size_t)(r8 + n) * (2 * K) + k0 + 8 * c) = o; }
    } else {
#pragma unroll
    for (int j = 0; j < 4; ++j) { const int n = (lane >> 3) + 8 * j; const LAS float* s = scr + (8 * c) * 33 + n;
        v4u o; o.x = cvtpk(s[0 * 33], s[1 * 33]); o.y = cvtpk(s[2 * 33], s[3 * 33]); o.z = cvtpk(s[4 * 33], s[5 * 33]); o.w = cvtpk(s[6 * 33], s[7 * 33]);
        *(GAS v4u*)(WT + (size_t)(n0 + n) * (ldo ? ldo : K) + k0 + 8 * c) = o; }
    }
    LDS_WAIT(); asm volatile("" ::: "memory");
}
__device__ __forceinline__ void p0_prologue(Frame& F, const Args& a, const bool with_mod) {
    LAS float* scr = (LAS float*)(F.lds + RING_OFF + F.wave * 16384);
    const int gw = F.vcu * NWAVES + F.wave, NGW = F.G * NWAVES, lane = F.lane;
    constexpr int I_IN = (DM / 64) * (DIN / 32), I_SQ = (DM / 64) * (DM / 32), I_GT = NCB * (CBW / 64) * (CBW / 32);
    constexpr int NITEMS = I_IN + 3 * I_SQ + 2 * I_GT;
    bf16* ws16 = (bf16*)a.ws;
    for (int it = gw; it < NITEMS; it += NGW) {
        int r = it;
        if (r < I_IN) { p0_transpose_item(a.in[5], DM, DIN, (bf16*)(a.ws + WS_WIN), scr, r, lane, 0, (F8Q == 1 && !I8Q) ? (unsigned char*)(a.ws + WS_WQ8) : nullptr, F8_MASK, WQ8_SCALE); continue; } r -= I_IN;
        if (r < I_SQ) { p0_transpose_item(a.in[14], DM, DM, (bf16*)(a.ws + WS_WCAT), scr, r, lane, 2 * DM); continue; } r -= I_SQ;
        if (r < I_SQ) { p0_transpose_item(a.in[15], DM, DM, (bf16*)(a.ws + WS_WCAT) + DM, scr, r, lane, 2 * DM); continue; } r -= I_SQ;
        if (r < I_SQ) { p0_transpose_item(a.in[16], DM, DM, (bf16*)(a.ws + WS_WOUT), scr, r, lane); continue; } r -= I_SQ;
        if (r < I_GT) { const int cbi = r >> 5; p0_transpose_item(a.in[8] + (size_t)cbi * 65536, CBW, CBW, (bf16*)(a.ws + WS_WGA) + (size_t)cbi * 65536, scr, r & 31, lane, 0, nullptr, 0u, 1.0f, GATE_WMUL); continue; } r -= I_GT;
        { const int cbi = r >> 5; p0_transpose_item(a.in[10] + (size_t)cbi * 65536, CBW, CBW, (bf16*)(a.ws + WS_WGX) + (size_t)cbi * 65536, scr, r & 31, lane, 0, nullptr, 0u, 1.0f, GATE_WMUL); }
    }
    (void)ws16;
    float* mod = (float*)(F.ctl + CW_MOD);
    if (with_mod) for (int task = gw; task < 48 * 32; task += NGW) {
        const int ec = task % 48, ds = task / 48;
        const float c0 = a.in[1][128 * ds + lane], c1 = a.in[1][128 * ds + 64 + lane];
        const float s0 = c0 / (1.0f + __expf(-c0)), s1 = c1 / (1.0f + __expf(-c1));
        f32x4 acc = {0.f, 0.f, 0.f, 0.f};
        const GAS f32x4* wp = (const GAS f32x4*)(a.in[2] + (size_t)(128 * ds) * 12288 + 256 * ec) + lane;
#pragma unroll 8
        for (int i = 0; i < 64; ++i) { const float s = __builtin_bit_cast(float, __builtin_amdgcn_readlane(__builtin_bit_cast(int, s0), i)); acc += wp[(size_t)i * 3072] * s; }
#pragma unroll 8
        for (int i = 0; i < 64; ++i) { const float s = __builtin_bit_cast(float, __builtin_amdgcn_readlane(__builtin_bit_cast(int, s1), i)); acc += wp[(size_t)(64 + i) * 3072] * s; }
        if (ds == 0) acc += *((const GAS f32x4*)(a.in[3] + 256 * ec) + lane);
        float* mp = mod + 256 * ec + 4 * lane;
        atomicAdd(mp + 0, acc[0]); atomicAdd(mp + 1, acc[1]); atomicAdd(mp + 2, acc[2]); atomicAdd(mp + 3, acc[3]);
    }
}

__device__ __forceinline__ void quant_row4096_load(v4u (&raw)[8], const unsigned char* p, int lane) {
    const GAS v4u* r = (const GAS v4u*)p + lane;
#pragma unroll
    for (int j = 0; j < 8; ++j) raw[j] = r[64 * j];
}
__device__ __forceinline__ float quant_row4096_finish(const v4u (&raw)[8], unsigned char* p, int lane) {
    float mx = 0.f;
#pragma unroll
    for (int j = 0; j < 8; ++j) { mx = fmaxf(mx, fmaxf(fmaxf(fabsf(bflo(raw[j].x)), fabsf(bfhi(raw[j].x))), fmaxf(fabsf(bflo(raw[j].y)), fabsf(bfhi(raw[j].y)))));
        mx = fmaxf(mx, fmaxf(fmaxf(fabsf(bflo(raw[j].z)), fabsf(bfhi(raw[j].z))), fmaxf(fabsf(bflo(raw[j].w)), fabsf(bfhi(raw[j].w))))); }
    mx = fmaxf(wave_max(mx), 1e-30f);
    const float q = 127.0f / mx;
    GAS v2u* o = (GAS v2u*)p + lane;
#pragma unroll
    for (int j = 0; j < 8; ++j) { v2u w; w.x = pk4_i8(bflo(raw[j].x) * q, bfhi(raw[j].x) * q, bflo(raw[j].y) * q, bfhi(raw[j].y) * q); w.y = pk4_i8(bflo(raw[j].z) * q, bfhi(raw[j].z) * q, bflo(raw[j].w) * q, bfhi(raw[j].w) * q); o[64 * j] = w; }
    return mx * (1.0f / 127.0f);
}
__device__ __forceinline__ float quant_row4096_inplace(unsigned char* p, int lane) { v4u raw[8]; quant_row4096_load(raw, p, lane); return quant_row4096_finish(raw, p, lane); }
__device__ __forceinline__ void p1_wrow(Frame& F, const Args& a, LAS float* GS, LAS float* SH, const v4u (&raw)[8], int c) {
    asm volatile("" ::: "memory");
    const int pn = pg8::f8_tile(c >> 8, F8_MASK), n = pn * 256 + (c & 255);
    float wp[8][8]; float mx = 0.f, bs = 0.f;
#pragma unroll
    for (int j = 0; j < 8; ++j) { const int k0 = 8 * F.lane + 512 * j; const f32x4 g0 = *(const LAS f32x4*)(GS + k0), g1 = *(const LAS f32x4*)(GS + k0 + 4), s0 = *(const LAS f32x4*)(SH + k0), s1 = *(const LAS f32x4*)(SH + k0 + 4);
        const float w0 = bflo(raw[j].x), w1 = bfhi(raw[j].x), w2 = bflo(raw[j].y), w3 = bfhi(raw[j].y), w4 = bflo(raw[j].z), w5 = bfhi(raw[j].z), w6 = bflo(raw[j].w), w7 = bfhi(raw[j].w);
        bs += (w0 * s0.x + w1 * s0.y) + (w2 * s0.z + w3 * s0.w) + (w4 * s1.x + w5 * s1.y) + (w6 * s1.z + w7 * s1.w);
        wp[j][0] = w0 * g0.x; wp[j][1] = w1 * g0.y; wp[j][2] = w2 * g0.z; wp[j][3] = w3 * g0.w; wp[j][4] = w4 * g1.x; wp[j][5] = w5 * g1.y; wp[j][6] = w6 * g1.z; wp[j][7] = w7 * g1.w;
#pragma unroll
        for (int e = 0; e < 8; ++e) mx = fmaxf(mx, fabsf(wp[j][e])); }
    mx = fmaxf(wave_max(mx), 1e-30f); bs = wave_sum(bs);
    const float qw = 127.0f / mx;
    GAS v2u* o = (GAS v2u*)((unsigned char*)(a.ws + WS_WQ8) + (size_t)c * (2 * DM)) + F.lane;
#pragma unroll
    for (int j = 0; j < 8; ++j) { v2u w; w.x = pk4_i8(wp[j][0] * qw, wp[j][1] * qw, wp[j][2] * qw, wp[j][3] * qw); w.y = pk4_i8(wp[j][4] * qw, wp[j][5] * qw, wp[j][6] * qw, wp[j][7] * qw); o[64 * j] = w; }
    if (F.lane == 0) { ((GAS float*)(F.ctl + CW_CS))[n] = mx * (1.0f / 127.0f); ((GAS float*)(F.ctl + CW_BIAS))[n] = bs; }
}

__device__ __forceinline__ void p1_hrows(Frame& F, const Args& a) {
    LAS float* GS = (LAS float*)(F.lds + RING_OFF); LAS float* SH = GS + DM;
    const GAS float* mod = (const GAS float*)(F.ctl + CW_MOD);
#if defined(MOD_NAIVE)
    { float* modw = (float*)(F.ctl + CW_MOD) + 3 * DM + 64;
      for (int e = F.tid; e < 3 * DM; e += NWAVES * 64) { double s = 0.0; for (int d = 0; d < DM; ++d) { const double cv = (double)a.in[1][d]; s += cv / (1.0 + exp(-cv)) * (double)a.in[2][(size_t)d * (3 * DM) + e]; } modw[e] = (float)(s + (double)a.in[3][e]); }
      __syncthreads(); mod = (const GAS float*)modw; }
#endif
    LAS float* SA = SH + DM; LAS float* SB = SA + DM;
    for (int d = F.tid; d < DM; d += NWAVES * 64) { const float sg = a.in[4][d] * (1.0f + mod[DM + d]); GS[d] = sg; SH[d] = mod[d]; const float sa = sqrtf(fabsf(sg)); SA[d] = sa; SB[d] = sa > 0.f ? sg / sa : 0.f; }
    __syncthreads();
    const int gw = F.vcu * NWAVES + F.wave, NGW = F.G * NWAVES;
    bf16* H = (bf16*)(a.ws + WS_H);
#pragma unroll 1
    for (int m = gw; m < SEQ; m += NGW) {
        asm volatile("" ::: "memory");
        const GAS f32x4* xr = (const GAS f32x4*)(a.in[0] + (size_t)m * DM) + F.lane;
        f32x4 v[16]; float s = 0.f;
#pragma unroll
        for (int j = 0; j < 16; ++j) { v[j] = __builtin_nontemporal_load(xr + 64 * j); s += (v[j].x * v[j].x + v[j].y * v[j].y) + (v[j].z * v[j].z + v[j].w * v[j].w); }
        const float rstd = 1.0f / sqrtf(wave_sum(s) * (1.0f / DM) + EPS);
        GAS v2u* o8 = (GAS v2u*)(H + (size_t)m * DM) + F.lane;
        float qk = 0.f;
        if (F8Q && I8Q) {
            float mx = 0.f;
#pragma unroll
            for (int j = 0; j < 16; ++j) { const f32x4 t = v[j] * *(const LAS f32x4*)(SA + 4 * F.lane + 256 * j); mx = fmaxf(mx, fmaxf(fmaxf(fabsf(t.x), fabsf(t.y)), fmaxf(fabsf(t.z), fabsf(t.w)))); if (ALL_LOWP) v[j] = t; }
            mx = fmaxf(wave_max(mx), 1e-30f);
            qk = 127.0f / mx;
            if (F.lane == 0) ((GAS float*)(F.ctl + CW_RS))[m] = mx * rstd * (1.0f / 127.0f);
        }
#pragma unroll
        for (int j = 0; j < 16; ++j) { const int col = 4 * F.lane + 256 * j;
            if (ALL_LOWP) { *(GAS unsigned*)((unsigned char*)(a.ws + WS_H8) + (size_t)m * (2 * DM) + col) = pk4_i8(v[j].x * qk, v[j].y * qk, v[j].z * qk, v[j].w * qk); continue; }
            const f32x4 g = *(const LAS f32x4*)(GS + col), sh = *(const LAS f32x4*)(SH + col);
            const f32x4 o = v[j] * rstd * g + sh; v2u w; w.x = cvtpk(o.x, o.y); w.y = cvtpk(o.z, o.w); o8[64 * j] = w;
            if (F8Q && I8Q) { const f32x4 t = v[j] * *(const LAS f32x4*)(SA + col); *(GAS unsigned*)((unsigned char*)(a.ws + WS_H8) + (size_t)m * (2 * DM) + col) = pk4_i8(t.x * qk, t.y * qk, t.z * qk, t.w * qk); }
            else if (F8Q) *(GAS unsigned*)((unsigned char*)(a.ws + WS_H8) + (size_t)m * (2 * DM) + col) = pk4_fp8(o.x, o.y, o.z, o.w); }
    }
    if (F8Q && I8Q) {
        const int ncol = pg8::f8_count(F8_MASK) * 256;
        const bf16* WT = (const bf16*)(a.ws + WS_WIN);
        v4u rawA[8], rawB[8];
#define P1_WLOAD(raw, c_) do { const int pn_ = pg8::f8_tile((c_) >> 8, F8_MASK), n_ = pn_ * 256 + ((c_) & 255); const GAS v4u* wr_ = (const GAS v4u*)(WT + (size_t)n_ * DM) + F.lane; \
            _Pragma("unroll") for (int j = 0; j < 8; ++j) raw[j] = wr_[64 * j]; } while (0)
        int c = gw;
        if (c < ncol) P1_WLOAD(rawA, c);
#pragma unroll 1
        while (c < ncol) {
            const int c1 = c + NGW, c2 = c1 + NGW;
            if (c1 < ncol) P1_WLOAD(rawB, c1);
            __builtin_amdgcn_sched_barrier(0);
            p1_wrow(F, a, SB, SH, rawA, c);
            if (c1 >= ncol) break;
            if (c2 < ncol) P1_WLOAD(rawA, c2);
            __builtin_amdgcn_sched_barrier(0);
            p1_wrow(F, a, SB, SH, rawB, c1);
            c = c2;
        }
#undef P1_WLOAD
    }
    if (I8A) {
#pragma unroll 1
        for (int n = gw; n < DM; n += NGW) { asm volatile("" ::: "memory");
            const float sc = quant_row4096_inplace((unsigned char*)(a.ws + WS_WCAT) + (size_t)n * (4 * DM) + 2 * DM, F.lane);
            if (F.lane == 0) ((GAS float*)(F.ctl + CW_CS2))[n] = sc; }
    }
}
__device__ __forceinline__ void p4q_rows(Frame& F, const Args& a) {
    const int gw = F.vcu * NWAVES + F.wave, NGW = F.G * NWAVES;
    unsigned char* base = (unsigned char*)(a.ws + WS_Y2) + 2 * DM;
    GAS float* RSo = (GAS float*)(F.ctl + CW_RS2);
    v4u rawA[8], rawB[8];
    int m = gw;
    if (m < SEQ) quant_row4096_load(rawA, base + (size_t)m * (4 * DM), F.lane);
#pragma unroll 1
    while (m < SEQ) {
        const int m1 = m + NGW, m2 = m1 + NGW;
        if (m1 < SEQ) quant_row4096_load(rawB, base + (size_t)m1 * (4 * DM), F.lane);
        __builtin_amdgcn_sched_barrier(0);
        { const float sc = quant_row4096_finish(rawA, base + (size_t)m * (4 * DM), F.lane); if (F.lane == 0) RSo[m] = sc; }
        if (m1 >= SEQ) break;
        if (m2 < SEQ) quant_row4096_load(rawA, base + (size_t)m2 * (4 * DM), F.lane);
        __builtin_amdgcn_sched_barrier(0);
        { const float sc = quant_row4096_finish(rawB, base + (size_t)m1 * (4 * DM), F.lane); if (F.lane == 0) RSo[m1] = sc; }
        m = m2;
    }
}

constexpr int APITCH = 528, ATILE = 64 * APITCH;
template <int PASS, int VAR = 0>
__device__ __forceinline__ void scan_pass(Frame& F, const Args& a, float* AGG) {
    LAS unsigned char* AT0 = F.lds + RING_OFF;
    LAS float* CW = (LAS float*)(F.lds + RING_OFF + 2 * ATILE);
    const int tid = F.tid, lane = F.lane, w = F.wave, q = lane >> 4, j = lane & 15;
    const bf16* U = (const bf16*)(a.ws + WS_U); const bf16* Gr = (const bf16*)(a.ws + WS_G); bf16* Y = (bf16*)(a.ws + WS_Y2);
    bf16* LA = (bf16*)(a.ws + WS_LA); bf16* BB = (bf16*)(a.ws + WS_BB);
    const int tg = tid >> 5, cg = tid & 31;
    for (int vb = blockIdx.x; vb < 256; vb += gridDim.x) {
        const int seg = vb & 7, half = (vb >> 3) & 1, cb = vb >> 4;
        __syncthreads();
        for (int i = tid; i < 5 * 256; i += NWAVES * 64) { const int k = i >> 8, c = i & 255; CW[i] = (k < 4) ? a.in[6][k * DM + cb * CBW + c] : a.in[7][cb * CBW + c]; }
        const int chl = half * 128 + 16 * w + j, ch = cb * CBW + chl;
        bf16x8 wa[8], wx[8];
        { const GAS bf16x8* pa = (const GAS bf16x8*)((const bf16*)(a.ws + WS_WGA) + (size_t)ch * CBW + 8 * q); const GAS bf16x8* px = (const GAS bf16x8*)((const bf16*)(a.ws + WS_WGX) + (size_t)ch * CBW + 8 * q);
#pragma unroll
          for (int kk = 0; kk < 8; ++kk) { wa[kk] = pa[4 * kk]; wx[kk] = px[4 * kk]; } }
        const float ba = a.in[9][ch] * GATE_WMUL, bx = a.in[11][ch] * GATE_WMUL;
        const float cl = -8.0f * log1pf(expf(-a.in[12][ch]));
        const float cl2 = cl * LOG2E;
        float c = 0.f, Ac = 1.f;
        if (PASS == 2) for (int s = 0; s < 8 * seg; ++s) { const float2 ah = *(const float2*)(AGG + ((size_t)s * DM + ch) * 2); c = ah.x * c + ah.y; }
        const int NST = (PASS == 1) ? 28 : 32;
        const int t0 = (PASS == 1) ? seg * 1792 : seg * 2048;
        const bf16* ucol = U + cb * CBW + 8 * cg;
        v4u R[7];
#define SCAN_LOAD(tb) do { _Pragma("unroll") for (int rr = 0; rr < 7; ++rr) { const int t = (tb) + 4 * tg - 3 + rr; if (VAR & 1) R[rr] = (v4u){(unsigned)t, 0x3f803f80u, (unsigned)rr, 0x3f003f00u}; else R[rr] = (t >= 0) ? *(const GAS v4u*)(ucol + (size_t)t * DM) : (v4u){0u, 0u, 0u, 0u}; } } while (0)
#define SCAN_CONV(buf) do { \
            f32x4 wk[4][2]; _Pragma("unroll") for (int k = 0; k < 4; ++k) { wk[k][0] = *(const LAS f32x4*)(CW + k * 256 + 8 * cg); wk[k][1] = *(const LAS f32x4*)(CW + k * 256 + 8 * cg + 4); } \
            const f32x4 cb0 = *(const LAS f32x4*)(CW + 1024 + 8 * cg), cb1 = *(const LAS f32x4*)(CW + 1024 + 8 * cg + 4); \
            _Pragma("unroll") for (int tt = 0; tt < 4; ++tt) { f32x4 o0 = cb0, o1 = cb1; \
                if (VAR & 2) { *(LAS v4u*)(AT0 + (buf) * ATILE + (4 * tg + tt) * APITCH + cg * 16) = R[tt + 3]; continue; } \
                _Pragma("unroll") for (int k = 0; k < 4; ++k) { const v4u x = R[tt + k]; \
                    o0 += wk[k][0] * (f32x4){bflo(x.x), bfhi(x.x), bflo(x.y), bfhi(x.y)}; o1 += wk[k][1] * (f32x4){bflo(x.z), bfhi(x.z), bflo(x.w), bfhi(x.w)}; } \
                v4u ow; ow.x = cvtpk(o0[0], o0[1]); ow.y = cvtpk(o0[2], o0[3]); ow.z = cvtpk(o1[0], o1[1]); ow.w = cvtpk(o1[2], o1[3]); \
                *(LAS v4u*)(AT0 + (buf) * ATILE + (4 * tg + tt) * APITCH + cg * 16) = ow; } } while (0)
        __syncthreads();
        SCAN_LOAD(t0); SCAN_CONV(0);
        __syncthreads();
        for (int st = 0; st < NST; ++st) {
            if (st + 1 < NST) SCAN_LOAD(t0 + 64 * (st + 1));
            const LAS unsigned char* At = AT0 + (st & 1) * ATILE;
#pragma unroll
            for (int wt = 0; wt < 4; ++wt) {
                const int trow = 16 * wt, tglob = t0 + 64 * st + trow + 4 * q;
                unsigned short gbits[4];
                if (PASS == 2) {
#pragma unroll
                    for (int v = 0; v < 4; ++v) gbits[v] = *(const GAS unsigned short*)(Gr + (size_t)(tglob + v) * DM + ch); }
                f32x4 accA = {0.f, 0.f, 0.f, 0.f}, accX = {0.f, 0.f, 0.f, 0.f};
                if (GATE_PRESCALE && VAR == 0) { accA = (f32x4){ba, ba, ba, ba}; accX = (f32x4){bx, bx, bx, bx}; }
#pragma unroll
                for (int kk = 0; kk < 8; ++kk) { if ((VAR & 32) && kk > 0) continue; const bf16x8 af = *(const LAS bf16x8*)(At + (trow + j) * APITCH + kk * 64 + q * 16);
                    if (VAR & 4) { accA[kk & 3] += __builtin_bit_cast(float, (int)af[0] << 16); accX[kk & 3] += __builtin_bit_cast(float, (int)af[5] << 16); }
                    else { accA = __builtin_amdgcn_mfma_f32_16x16x32_bf16(af, wa[kk], accA, 0, 0, 0); accX = __builtin_amdgcn_mfma_f32_16x16x32_bf16(af, wx[kk], accX, 0, 0, 0); } }
                float av[4], bv[4];
#pragma unroll
                for (int v = 0; v < 4; ++v) {
                    const float uval = __builtin_bit_cast(float, (unsigned)(*(const LAS unsigned short*)(At + (trow + 4 * q + v) * APITCH + chl * 2)) << 16);
                    if (VAR & 8) { av[v] = accA[v] * 0.25f + ba; bv[v] = accX[v] * uval + bx; continue; }
                    float r, ii;
                    if (GATE_PRESCALE && VAR == 0) { r = __builtin_amdgcn_rcpf(1.0f + __builtin_amdgcn_exp2f(accA[v])); ii = __builtin_amdgcn_rcpf(1.0f + __builtin_amdgcn_exp2f(accX[v])); }
                    else { r = sigmoid_f(accA[v] + ba), ii = sigmoid_f(accX[v] + bx); }
                    const float la2 = cl2 * r;
                    const float aa = __builtin_amdgcn_exp2f(la2);
                    const float om = __builtin_fmaf(-aa, aa, 1.0f);
                    av[v] = aa; bv[v] = __builtin_amdgcn_sqrtf(om) * (ii * uval);
#if defined(SCAN_STORED)
                    if (PASS == 1) { const unsigned pk = cvtpk(la2, bv[v]); *(GAS unsigned short*)(LA + (size_t)(tglob + v) * DM + ch) = (unsigned short)(pk & 0xffffu); *(GAS unsigned short*)(BB + (size_t)(tglob + v) * DM + ch) = (unsigned short)(pk >> 16);
                        av[v] = __builtin_amdgcn_exp2f(bflo(pk)); bv[v] = bfhi(pk); }
#endif
                }
                float A = av[0], Hh = bv[0];
#pragma unroll
                for (int v = 1; v < 4; ++v) { Hh = av[v] * Hh + bv[v]; A = A * av[v]; }
                if (!(VAR & 16)) { const float A1 = __shfl_up(A, 16), H1 = __shfl_up(Hh, 16); if (q >= 1) { Hh = A * H1 + Hh; A = A * A1; } }
                if (!(VAR & 16)) { const float A2 = __shfl_up(A, 32), H2 = __shfl_up(Hh, 32); if (q >= 2) { Hh = A * H2 + Hh; A = A * A2; } }
                if (PASS == 2) {
                    float Aex = __shfl_up(A, 16), Hex = __shfl_up(Hh, 16); if (q == 0) { Aex = 1.0f; Hex = 0.0f; }
                    float h = Aex * c + Hex;
#pragma unroll
                    for (int v = 0; v < 4; ++v) { h = av[v] * h + bv[v];
                        const float g = __builtin_bit_cast(float, (unsigned)gbits[v] << 16);
                        *(GAS unsigned short*)(Y + (size_t)(tglob + v) * (2 * DM) + ch) = (unsigned short)(cvtpk(h * g, 0.f) & 0xffffu); }
                }
                const float At_ = (VAR & 16) ? A : __shfl(A, 48 + j), Ht_ = (VAR & 16) ? Hh : __shfl(Hh, 48 + j);
                c = At_ * c + Ht_; Ac = Ac * At_;
            }
            if (st + 1 < NST) SCAN_CONV((st + 1) & 1);
            if (PASS == 1 && (st & 3) == 3) { if (q == 0) *(float2*)(AGG + ((size_t)(seg * 7 + (st >> 2)) * DM + ch) * 2) = make_float2(Ac, c); c = 0.f; Ac = 1.f; }
            __syncthreads();
        }
#undef SCAN_LOAD
#undef SCAN_CONV
    }
}


template <int PASS, int NT>
__device__ __forceinline__ void scan_dma(Frame& F, const Args& a, float* AGG) {
    constexpr int NSEG = (NT == 1) ? 8 : 16, SEGLEN = SEQ / NSEG, NST = SEGLEN / 64;
    LAS unsigned char* AT0 = F.lds + RING_OFF;
    const int lane = F.lane, w = F.wave, q = lane >> 4, j = lane & 15;
    const bf16* UC = (const bf16*)(a.ws + WS_UC); const bf16* Gr = (const bf16*)(a.ws + WS_G); bf16* Y = (bf16*)(a.ws + WS_Y2);
    for (int vb = blockIdx.x; vb < 256; vb += gridDim.x) {
        const int seg = vb & (NSEG - 1), half = (NT == 1) ? ((vb >> 3) & 1) : 0, cb = vb >> 4;
        if (PASS == 1 && seg == NSEG - 1) continue;
        const int chl0 = (NT == 1) ? (half * 128 + 16 * w + j) : (32 * w + j), ch0 = cb * CBW + chl0;
        bf16x8 wa[NT][8], wx[NT][8]; float ba[NT], bx[NT], cl2[NT], c[NT], Ac[NT];
#pragma unroll
        for (int nt = 0; nt < NT; ++nt) { const int ch = ch0 + 16 * nt;
            const GAS bf16x8* pa = (const GAS bf16x8*)((const bf16*)(a.ws + WS_WGA) + (size_t)ch * CBW + 8 * q); const GAS bf16x8* px = (const GAS bf16x8*)((const bf16*)(a.ws + WS_WGX) + (size_t)ch * CBW + 8 * q);
#pragma unroll
            for (int kk = 0; kk < 8; ++kk) { wa[nt][kk] = pa[4 * kk]; wx[nt][kk] = px[4 * kk]; }
            ba[nt] = a.in[9][ch]; bx[nt] = a.in[11][ch]; cl2[nt] = -8.0f * log1pf(expf(-a.in[12][ch])) * LOG2E;
            c[nt] = 0.f; Ac[nt] = 1.f;
            if (PASS == 2) for (int s = 0; s < seg; ++s) { const float2 ah = *(const float2*)(AGG + ((size_t)s * DM + ch) * 2); c[nt] = ah.x * c[nt] + ah.y; } }
        const int t0 = seg * SEGLEN;
        const bf16* dsrc[4];
#pragma unroll
        for (int d = 0; d < 4; ++d) { const int r64 = 8 * w + 2 * d + (lane >> 5); dsrc[d] = UC + (size_t)(t0 + r64) * UCP + cb * CBW + (((lane & 31) ^ (r64 & 15)) << 3); }
        const bf16* gsrc = Gr + (size_t)(t0 + 4 * q) * DM + ch0;
#define SD_ISSUE(st_, buf_) do { _Pragma("unroll") for (int d = 0; d < 4; ++d) \
            __builtin_amdgcn_global_load_lds((const unsigned*)(dsrc[d] + (size_t)(st_) * 64 * UCP), (LAS unsigned*)(AT0 + (buf_) * 32768 + (8 * w + 2 * d) * 512), 16, 0, 0); } while (0)
#define SD_GLOAD(st_, g_) do { if (PASS == 2) { _Pragma("unroll") for (int nt = 0; nt < NT; ++nt) _Pragma("unroll") for (int e = 0; e < 16; ++e) g_[nt][e] = *(const GAS unsigned short*)(gsrc + (size_t)((st_) * 64 + 16 * (e >> 2) + (e & 3)) * DM + 16 * nt); } } while (0)
#define SD_TILE(st_, gcur_, gnxt_) do { \
            if ((st_) + 1 < NST) { SD_ISSUE((st_) + 1, ((st_) + 1) & 1); if (NT == 1) SD_GLOAD((st_) + 1, gnxt_); } \
            asm volatile("" ::: "memory"); __builtin_amdgcn_sched_barrier(0); \
            const LAS unsigned char* At = AT0 + ((st_) & 1) * 32768; \
            _Pragma("unroll") for (int wt = 0; wt < 4; ++wt) { \
                if (NT == 2) __builtin_amdgcn_sched_barrier(0);     \
                const int trow = 16 * wt, tglob = t0 + 64 * (st_) + trow + 4 * q; \
                f32x4 accA[NT], accX[NT]; unsigned gw[NT][4];     \
                if (NT == 2 && PASS == 2) { _Pragma("unroll") for (int nt = 0; nt < NT; ++nt) _Pragma("unroll") for (int v = 0; v < 4; ++v) gw[nt][v] = *(const GAS unsigned short*)(gsrc + (size_t)((st_) * 64 + trow + v) * DM + 16 * nt); } \
                _Pragma("unroll") for (int nt = 0; nt < NT; ++nt) { accA[nt] = (f32x4){0.f, 0.f, 0.f, 0.f}; accX[nt] = (f32x4){0.f, 0.f, 0.f, 0.f}; } \
                _Pragma("unroll") for (int kk = 0; kk < 8; ++kk) { const bf16x8 af = *(const LAS bf16x8*)(At + (trow + j) * 512 + (((4 * kk + q) ^ j) << 4)); \
                    _Pragma("unroll") for (int nt = 0; nt < NT; ++nt) { accA[nt] = __builtin_amdgcn_mfma_f32_16x16x32_bf16(af, wa[nt][kk], accA[nt], 0, 0, 0); accX[nt] = __builtin_amdgcn_mfma_f32_16x16x32_bf16(af, wx[nt][kk], accX[nt], 0, 0, 0); } } \
                _Pragma("unroll") for (int nt = 0; nt < NT; ++nt) { \
                    const int chl = chl0 + 16 * nt; \
                    float av[4], bv[4]; \
                    _Pragma("unroll") for (int v = 0; v < 4; ++v) { \
                        const int rr = trow + 4 * q + v; \
                        const float uval = __builtin_bit_cast(float, (unsigned)(*(const LAS unsigned short*)(At + rr * 512 + ((((chl >> 3) ^ (rr & 15)) << 4) | ((chl & 7) << 1)))) << 16); \
                        const float r = sigmoid_f(accA[nt][v] + ba[nt]), ii = sigmoid_f(accX[nt][v] + bx[nt]); \
                        const float aa = __builtin_amdgcn_exp2f(cl2[nt] * r); \
                        const float om = __builtin_fmaf(-aa, aa, 1.0f); \
                        av[v] = aa; bv[v] = __builtin_amdgcn_sqrtf(om) * (ii * uval); } \
                    float A = av[0], Hh = bv[0]; \
                    _Pragma("unroll") for (int v = 1; v < 4; ++v) { Hh = av[v] * Hh + bv[v]; A = A * av[v]; } \
                    { const float A1 = __shfl_up(A, 16), H1 = __shfl_up(Hh, 16); if (q >= 1) { Hh = A * H1 + Hh; A = A * A1; } } \
                    { const float A2 = __shfl_up(A, 32), H2 = __shfl_up(Hh, 32); if (q >= 2) { Hh = A * H2 + Hh; A = A * A2; } } \
                    if (PASS == 2) { \
                        float Aex = __shfl_up(A, 16), Hex = __shfl_up(Hh, 16); if (q == 0) { Aex = 1.0f; Hex = 0.0f; } \
                        float h = Aex * c[nt] + Hex; \
                        _Pragma("unroll") for (int v = 0; v < 4; ++v) { h = av[v] * h + bv[v]; \
                            const float g = __builtin_bit_cast(float, ((NT == 2) ? gw[nt][v] : gcur_[nt][(NT == 2) ? 0 : (4 * wt + v)]) << 16); \
                            *(GAS unsigned short*)(Y + (size_t)(tglob + v) * (2 * DM) + ch0 + 16 * nt) = (unsigned short)(cvtpk(h * g, 0.f) & 0xffffu); } } \
                    const float At_ = __shfl(A, 48 + j), Ht_ = __shfl(Hh, 48 + j); \
                    c[nt] = At_ * c[nt] + Ht_; Ac[nt] = Ac[nt] * At_; } } \
              \
            if (PASS == 2) { if (NT == 1) asm volatile("s_waitcnt vmcnt(16) lgkmcnt(0)" ::: "memory"); else asm volatile("s_waitcnt vmcnt(8) lgkmcnt(0)" ::: "memory"); }     \
            else asm volatile("s_waitcnt vmcnt(0) lgkmcnt(0)" ::: "memory"); \
            __builtin_amdgcn_s_barrier(); asm volatile("" ::: "memory"); } while (0)
        unsigned gA[NT][(NT == 1) ? 16 : 1], gB[1][(NT == 1) ? 16 : 1];
        __syncthreads();
        SD_ISSUE(0, 0); if (NT == 1) SD_GLOAD(0, gA);
        asm volatile("s_waitcnt vmcnt(0)" ::: "memory"); __builtin_amdgcn_s_barrier(); asm volatile("" ::: "memory");
#pragma unroll 1
        for (int st = 0; st < NST; st += 2) { if (NT == 1) { SD_TILE(st, gA, gB); SD_TILE(st + 1, gB, gA); } else { SD_TILE(st, gA, gA); SD_TILE(st + 1, gA, gA); } }
        if (PASS == 1 && q == 0) {
#pragma unroll
            for (int nt = 0; nt < NT; ++nt) *(float2*)(AGG + ((size_t)seg * DM + ch0 + 16 * nt) * 2) = make_float2(Ac[nt], c[nt]); }
#undef SD_ISSUE
#undef SD_GLOAD
#undef SD_TILE
    }
}

__device__ __forceinline__ void scan_light(Frame& F, const Args& a) {
    const int lane = F.lane, w = F.wave, q = lane >> 4, j = lane & 15;
    const bf16* LA = (const bf16*)(a.ws + WS_LA); const bf16* BB = (const bf16*)(a.ws + WS_BB); const bf16* Gr = (const bf16*)(a.ws + WS_G); bf16* Y = (bf16*)(a.ws + WS_Y2);
    const float* AGG = (const float*)(a.ws + WS_AGG);
    for (int vb = blockIdx.x; vb < 256; vb += gridDim.x) {
        const int seg = vb & 7, half = (vb >> 3) & 1, cb = vb >> 4;
        const int ch = cb * CBW + half * 128 + 16 * w + j;
        float c = 0.f;
        for (int s = 0; s < seg; ++s) { const float2 ah = *(const float2*)(AGG + ((size_t)s * DM + ch) * 2); c = ah.x * c + ah.y; }
        const size_t base = (size_t)(seg * 2048 + 16 * q) * DM + ch;
        unsigned l0[16], b0[16], g0[16], l1[16], b1[16], g1[16];
#define SL_LOAD(tile, l_, b_, g_) do { _Pragma("unroll") for (int v = 0; v < 16; ++v) { const size_t o_ = base + (size_t)((tile) * 64 + v) * DM; \
            l_[v] = *(const GAS unsigned short*)(LA + o_); b_[v] = *(const GAS unsigned short*)(BB + o_); g_[v] = *(const GAS unsigned short*)(Gr + o_); } } while (0)
#define SL_TILE(tile, l_, b_, g_) do { \
            float av[16], A, Hh; \
            _Pragma("unroll") for (int v = 0; v < 16; ++v) av[v] = __builtin_amdgcn_exp2f(__builtin_bit_cast(float, l_[v] << 16)); \
            A = av[0]; Hh = __builtin_bit_cast(float, b_[0] << 16); \
            _Pragma("unroll") for (int v = 1; v < 16; ++v) { Hh = av[v] * Hh + __builtin_bit_cast(float, b_[v] << 16); A = A * av[v]; } \
            { const float A1 = __shfl_up(A, 16), H1 = __shfl_up(Hh, 16); if (q >= 1) { Hh = A * H1 + Hh; A = A * A1; } } \
            { const float A2 = __shfl_up(A, 32), H2 = __shfl_up(Hh, 32); if (q >= 2) { Hh = A * H2 + Hh; A = A * A2; } } \
            float Aex = __shfl_up(A, 16), Hex = __shfl_up(Hh, 16); if (q == 0) { Aex = 1.0f; Hex = 0.0f; } \
            float h = Aex * c + Hex; \
            _Pragma("unroll") for (int v = 0; v < 16; ++v) { h = av[v] * h + __builtin_bit_cast(float, b_[v] << 16); \
                *(GAS unsigned short*)(Y + ((size_t)(seg * 2048 + 16 * q + (tile) * 64 + v)) * (2 * DM) + ch) = (unsigned short)(cvtpk(h * __builtin_bit_cast(float, g_[v] << 16), 0.f) & 0xffffu); } \
            const float At_ = __shfl(A, 48 + j), Ht_ = __shfl(Hh, 48 + j); c = At_ * c + Ht_; } while (0)
        SL_LOAD(0, l0, b0, g0);
#pragma unroll 1
        for (int tile = 0; tile < 32; tile += 2) {
            SL_LOAD(tile + 1, l1, b1, g1);
            SL_TILE(tile, l0, b0, g0);
            if (tile + 2 < 32) SL_LOAD(tile + 2, l0, b0, g0);
            SL_TILE(tile + 1, l1, b1, g1);
        }
#undef SL_LOAD
#undef SL_TILE
    }
}

__device__ __forceinline__ void conv_pass(Frame& F, const Args& a) {
    const bf16* U = (const bf16*)(a.ws + WS_U); bf16* UC = (bf16*)(a.ws + WS_UC);
    const int gt = (int)blockIdx.x * (NWAVES * 64) + F.tid, cg = gt & 511, tstep = (F.G * NWAVES * 64) >> 9;
    f32x4 wk[4][2];
#pragma unroll
    for (int k = 0; k < 4; ++k) { wk[k][0] = *(const GAS f32x4*)(a.in[6] + k * DM + 8 * cg); wk[k][1] = *(const GAS f32x4*)(a.in[6] + k * DM + 8 * cg + 4); }
    const f32x4 cb0 = *(const GAS f32x4*)(a.in[7] + 8 * cg), cb1 = *(const GAS f32x4*)(a.in[7] + 8 * cg + 4);
#pragma unroll 1
    for (int tg = gt >> 9; tg < SEQ / 4; tg += tstep) {
        const int t = 4 * tg; v4u R[7];
#pragma unroll
        for (int rr = 0; rr < 7; ++rr) { const int tt = t - 3 + rr; R[rr] = (tt >= 0) ? *(const GAS v4u*)(U + (size_t)tt * DM + 8 * cg) : (v4u){0u, 0u, 0u, 0u}; }
#pragma unroll
        for (int tt = 0; tt < 4; ++tt) { f32x4 o0 = cb0, o1 = cb1;
#pragma unroll
            for (int k = 0; k < 4; ++k) { const v4u x = R[tt + k];
                o0 += wk[k][0] * (f32x4){bflo(x.x), bfhi(x.x), bflo(x.y), bfhi(x.y)}; o1 += wk[k][1] * (f32x4){bflo(x.z), bfhi(x.z), bflo(x.w), bfhi(x.w)}; }
            v4u ow; ow.x = cvtpk(o0[0], o0[1]); ow.y = cvtpk(o0[2], o0[3]); ow.z = cvtpk(o1[0], o1[1]); ow.w = cvtpk(o1[2], o1[3]);
            *(GAS v4u*)(UC + (size_t)(t + tt) * UCP + 8 * cg) = ow; }
    }
}

#ifndef AT16_VAR
#define AT16_VAR 0
#endif
__device__ __forceinline__ void scan_at16(Frame& F, const Args& a, bf16* Yout, const int ypitch) {
    typedef float f32x2v __attribute__((ext_vector_type(2)));
    LAS f32x2v* AGL = (LAS f32x2v*)(F.lds + RING_OFF);
    const int lane = F.lane, w = F.wave, q = lane >> 4, j = lane & 15;
    const bf16* UC = (const bf16*)(a.ws + WS_UC); const bf16* Gr = (const bf16*)(a.ws + WS_G); bf16* Y = Yout;
    for (int vb = blockIdx.x; vb < 256; vb += gridDim.x) {
        const int cb = (vb & 7) * 2 + (vb >> 7), c16 = (vb >> 3) & 15;
        const int chl = 16 * c16 + j, ch = cb * CBW + chl;
        bf16x8 wa[8], wx[8];
        { const GAS bf16x8* pa = (const GAS bf16x8*)((const bf16*)(a.ws + WS_WGA) + (size_t)ch * CBW + 8 * q); const GAS bf16x8* px = (const GAS bf16x8*)((const bf16*)(a.ws + WS_WGX) + (size_t)ch * CBW + 8 * q);
#pragma unroll
          for (int kk = 0; kk < 8; ++kk) { wa[kk] = pa[4 * kk]; wx[kk] = px[4 * kk]; } }
        const float ba = a.in[9][ch], bx = a.in[11][ch];
        const float cl2 = -8.0f * log1pf(expf(-a.in[12][ch])) * LOG2E;
        float C = 0.f;
        const bf16* arow = UC + (size_t)(16 * w + j) * UCP + cb * CBW + 8 * q;
        const bf16* grow = Gr + (size_t)(16 * w + 4 * q) * DM + ch; const bf16* urow = UC + (size_t)(16 * w + 4 * q) * UCP + ch;
        bf16x8 af0[8], af1[8]; unsigned g0[4], u0[4], g1[4], u1[4];
#define AT_LOAD(r_, af_, g_, u_) do { if (!(AT16_VAR & 32)) { _Pragma("unroll") for (int kk = 0; kk < 8; ++kk) af_[kk] = *(const GAS bf16x8*)(arow + (size_t)(r_) * 128 * UCP + 32 * kk); } \
            if (!(AT16_VAR & 16)) { _Pragma("unroll") for (int v = 0; v < 4; ++v) g_[v] = *(const GAS unsigned short*)(grow + ((size_t)(r_) * 128 + v) * DM); } } while (0)
#define AT_ROUND(r_, af_, g_, u_) do { \
            const int tl = 128 * (r_) + 16 * w + 4 * q; \
            unsigned uu_[4]; _Pragma("unroll") for (int v = 0; v < 4; ++v) uu_[v] = *(const GAS unsigned short*)(urow + ((size_t)(r_) * 128 + v) * UCP);     \
            f32x4 accA = {0.f, 0.f, 0.f, 0.f}, accX = {0.f, 0.f, 0.f, 0.f}; \
            if (!(AT16_VAR & 2)) { _Pragma("unroll") for (int kk = 0; kk < 8; ++kk) { accA = __builtin_amdgcn_mfma_f32_16x16x32_bf16(af_[kk], wa[kk], accA, 0, 0, 0); accX = __builtin_amdgcn_mfma_f32_16x16x32_bf16(af_[kk], wx[kk], accX, 0, 0, 0); } } else { accA[0] = __builtin_bit_cast(float, af_[0][0] | (af_[7][1] << 8)); accX[1] = __builtin_bit_cast(float, (int)af_[3][2]); } \
            float av[4], bv[4]; \
            _Pragma("unroll") for (int v = 0; v < 4; ++v) { \
                const float uval = __builtin_bit_cast(float, uu_[v] << 16); \
                if (!(AT16_VAR & 4)) { const float rg = sigmoid_f(accA[v] + ba), ii = sigmoid_f(accX[v] + bx); \
                const float aa = __builtin_amdgcn_exp2f(cl2 * rg); \
                const float om = __builtin_fmaf(-aa, aa, 1.0f); \
                av[v] = aa; bv[v] = __builtin_amdgcn_sqrtf(om) * (ii * uval); } else { av[v] = accA[v] * 0.5f + ba; bv[v] = accX[v] * uval + bx; } } \
            float A = av[0], Hh = bv[0]; \
            _Pragma("unroll") for (int v = 1; v < 4; ++v) { Hh = av[v] * Hh + bv[v]; A = A * av[v]; } \
            { const float A1 = __shfl_up(A, 16), H1 = __shfl_up(Hh, 16); if (q >= 1) { Hh = A * H1 + Hh; A = A * A1; } } \
            { const float A2 = __shfl_up(A, 32), H2 = __shfl_up(Hh, 32); if (q >= 2) { Hh = A * H2 + Hh; A = A * A2; } } \
            float Aex = __shfl_up(A, 16), Hex = __shfl_up(Hh, 16); if (q == 0) { Aex = 1.0f; Hex = 0.0f; } \
            LAS f32x2v* agr = AGL + ((r_) & 1) * 128; \
            if (q == 3) agr[w * 16 + j] = (f32x2v){A, Hh}; \
            asm volatile("s_waitcnt lgkmcnt(0)" ::: "memory"); if (!(AT16_VAR & 1)) __builtin_amdgcn_s_barrier(); asm volatile("" ::: "memory"); \
            f32x2v ag[8]; _Pragma("unroll") for (int e = 0; e < 8; ++e) ag[e] = agr[e * 16 + j]; \
            float cfull = C, cin = C; \
            _Pragma("unroll") for (int e = 0; e < 8; ++e) { cin = (e == w) ? cfull : cin; cfull = ag[e].x * cfull + ag[e].y; } \
            C = cfull; \
            float h = Aex * cin + Hex; \
            _Pragma("unroll") for (int v = 0; v < 4; ++v) { h = av[v] * h + bv[v]; \
                const float g = __builtin_bit_cast(float, g_[v] << 16); \
                if (!(AT16_VAR & 8) || h * g == 123.456f) *(GAS unsigned short*)(Y + (size_t)(tl + v) * ypitch + ch) = (unsigned short)(cvtpk(h * g, 0.f) & 0xffffu); } } while (0)
        bf16x8 af2[8]; unsigned g2[4], u2[4];
        AT_LOAD(0, af0, g0, u0); AT_LOAD(1, af1, g1, u1);
        __syncthreads();
        constexpr int NR = SEQ / 128;
#pragma unroll 1
        for (int r = 0; r < NR; r += 3) {
            if (r + 2 < NR) AT_LOAD(r + 2, af2, g2, u2);
            __builtin_amdgcn_sched_barrier(0);
            AT_ROUND(r, af0, g0, u0);
            __builtin_amdgcn_sched_barrier(0);
            if (r + 1 < NR) { if (r + 3 < NR) AT_LOAD(r + 3, af0, g0, u0);
                __builtin_amdgcn_sched_barrier(0);
                AT_ROUND(r + 1, af1, g1, u1); }
            __builtin_amdgcn_sched_barrier(0);
            if (r + 2 < NR) { if (r + 4 < NR) AT_LOAD(r + 4, af1, g1, u1);
                __builtin_amdgcn_sched_barrier(0);
                AT_ROUND(r + 2, af2, g2, u2); }
        }
#undef AT_LOAD
#undef AT_ROUND
        __syncthreads();
    }
}

constexpr int KP = 144, KBYTES = 192 * KP, ABUF = 2 * KBYTES;
__device__ __forceinline__ int crow(int reg, int h) { return (reg & 3) + 8 * (reg >> 2) + 4 * h; }
__device__ __forceinline__ void attn_phase(Frame& F, const Args& a) {
    LAS unsigned char* base = F.lds + RING_OFF;
    const int tid = F.tid, lane = F.lane, w = F.wave, r = lane & 31, hh = lane >> 5;
    const int i16 = lane & 15, q4 = i16 >> 2, p4 = i16 & 3, blk = (lane >> 4) & 1;
    const bf16* Q = (const bf16*)(a.ws + WS_Q); bf16* YA = (bf16*)(a.ws + WS_Y2) + DM; const bf16* Kg = (const bf16*)(a.ws + WS_K); const bf16* Vg = (const bf16*)(a.ws + WS_V); const bf16* GA = (const bf16*)(a.ws + WS_GA);
    constexpr int NUNITS = NKVH * (SEQ / 64);
    const int G = F.G;
    if ((int)blockIdx.x >= NUNITS) return;
    const int nloc = (NUNITS - (int)blockIdx.x + G - 1) / G;
    v4u pk[3], pv[3];
#define ATT_LOAD(u) do { const int hk_ = (u) >> 8, q0_ = 64 * ((u) & 255); _Pragma("unroll") for (int i = 0; i < 3; ++i) { const int p = tid + 512 * i, row = p >> 3, pc = p & 7, t = q0_ - 128 + row; \
            if (t >= 0) { pk[i] = *(const GAS v4u*)(Kg + (size_t)t * DKV + hk_ * HD + pc * 8); pv[i] = *(const GAS v4u*)(Vg + (size_t)t * DKV + hk_ * HD + pc * 8); } \
            else { pk[i] = (v4u){0u, 0u, 0u, 0u}; pv[i] = (v4u){0u, 0u, 0u, 0u}; } } } while (0)
#define ATT_WRITE(buf) do { _Pragma("unroll") for (int i = 0; i < 3; ++i) { const int p = tid + 512 * i, row = p >> 3, pc = p & 7; \
            *(LAS v4u*)(base + (buf) * ABUF + row * KP + pc * 16) = pk[i]; *(LAS v4u*)(base + (buf) * ABUF + KBYTES + row * KP + pc * 16) = pv[i]; } } while (0)
#define ATT_Q(it_, qt_, bq_) do { const int u_ = (it_) * G + (int)blockIdx.x, q0w_ = 64 * (u_ & 255) + 32 * (qt_), head_ = (u_ >> 8) * 8 + w; \
            const GAS bf16x8* qp_ = (const GAS bf16x8*)(Q + (size_t)(q0w_ + r) * DM + head_ * HD + 8 * hh); _Pragma("unroll") for (int s_ = 0; s_ < 4; ++s_) bq_[s_] = qp_[2 * s_]; } while (0)
#define ATT_TASK(it_, qt_, bq_) do { \
        const int u = (it_) * G + (int)blockIdx.x; \
        const LAS unsigned char* Kb = base + ((it_) & 1) * ABUF; const LAS unsigned char* Vb = Kb + KBYTES; \
        const int hk = u >> 8, q0 = 64 * (u & 255), head = hk * 8 + w; \
        const float sink2 = SK[head] * LOG2E; \
        const int q0w = q0 + 32 * (qt_); \
        v4u gq_[4];     \
        _Pragma("unroll") for (int p = 0; p < 4; ++p) gq_[p] = *(const GAS v4u*)(GA + (size_t)(q0w + r) * DM + head * HD + 16 * p + 8 * hh); \
        f32x16 x[5]; \
        _Pragma("unroll") for (int jt = 0; jt < 5; ++jt) { \
            _Pragma("unroll") for (int i = 0; i < 16; ++i) x[jt][i] = 0.f; \
            _Pragma("unroll") for (int s = 0; s < 4; ++s) { const bf16x8 kf = *(const LAS bf16x8*)(Kb + (32 * (qt_) + 32 * jt + r) * KP + (16 * s + 8 * hh) * 2); \
                x[jt] = __builtin_amdgcn_mfma_f32_32x32x16_bf16(kf, bq_[s], x[jt], 0, 0, 0); } } \
          \
        const int jt_min = (q0w >= 128) ? 0 : (4 - (q0w >> 5)); \
        const float NEG = -__builtin_inff(); \
        float m = sink2; \
        _Pragma("unroll") for (int jt = 0; jt < 5; ++jt) { \
            _Pragma("unroll") for (int i = 0; i < 16; ++i) { const int cr = crow(i, hh); bool ok = jt >= jt_min; if (jt == 0) ok = ok && (cr > r); if (jt == 4) ok = ok && (cr <= r); \
                const float v = ok ? x[jt][i] : NEG; x[jt][i] = v; m = fmaxf(m, v); } } \
        m = fmaxf(m, __shfl_xor(m, 32)); \
        float l = 0.f; \
        _Pragma("unroll") for (int jt = 0; jt < 5; ++jt) { \
            _Pragma("unroll") for (int i = 0; i < 16; ++i) { const float p = __builtin_amdgcn_exp2f(x[jt][i] - m); x[jt][i] = p; l += p; } } \
        l += __shfl_xor(l, 32); l += __builtin_amdgcn_exp2f(sink2 - m); \
        f32x16 o[2]; \
        _Pragma("unroll") for (int i = 0; i < 16; ++i) { o[0][i] = 0.f; o[1][i] = 0.f; } \
        _Pragma("unroll") for (int jt = 0; jt < 5; ++jt) { \
            _Pragma("unroll") for (int s = 0; s < 2; ++s) { \
                v4u pw; pw.x = cvtpk(x[jt][8 * s + 0], x[jt][8 * s + 1]); pw.y = cvtpk(x[jt][8 * s + 2], x[jt][8 * s + 3]); pw.z = cvtpk(x[jt][8 * s + 4], x[jt][8 * s + 5]); pw.w = cvtpk(x[jt][8 * s + 6], x[jt][8 * s + 7]); \
                const bf16x8 pf = __builtin_bit_cast(bf16x8, pw); \
                _Pragma("unroll") for (int dt = 0; dt < 2; ++dt) { \
                    const LAS unsigned char* vp = Vb + (32 * (qt_) + 32 * jt + 16 * s + 4 * hh + q4) * KP + (32 * dt + 16 * blk) * 2 + 8 * p4; \
                    const s16x4 lo = __builtin_bit_cast(s16x4, __builtin_amdgcn_ds_read_tr16_b64_v4i16((LAS s16x4*)vp)); \
                    const s16x4 hi = __builtin_bit_cast(s16x4, __builtin_amdgcn_ds_read_tr16_b64_v4i16((LAS s16x4*)(vp + 8 * KP))); \
                    const bf16x8 vf = __builtin_shufflevector(lo, hi, 0, 1, 2, 3, 4, 5, 6, 7); \
                    o[dt] = __builtin_amdgcn_mfma_f32_32x32x16_bf16(vf, pf, o[dt], 0, 0, 0); } } } \
        const float inv = 1.0f / l; \
          \
        _Pragma("unroll") for (int p = 0; p < 4; ++p) { \
            v4u gq = gq_[p];     \
            { auto t0 = __builtin_amdgcn_permlane32_swap(gq.x, gq.z, false, false); gq.x = t0[0]; gq.z = t0[1]; auto t1 = __builtin_amdgcn_permlane32_swap(gq.y, gq.w, false, false); gq.y = t1[0]; gq.w = t1[1]; } \
            const int ka = 2 * p, kb = 2 * p + 1; \
            v2u oa, ob; \
            oa.x = cvtpk(o[ka >> 2][4 * (ka & 3) + 0] * inv * bflo(gq.x), o[ka >> 2][4 * (ka & 3) + 1] * inv * bfhi(gq.x)); oa.y = cvtpk(o[ka >> 2][4 * (ka & 3) + 2] * inv * bflo(gq.y), o[ka >> 2][4 * (ka & 3) + 3] * inv * bfhi(gq.y)); \
            ob.x = cvtpk(o[kb >> 2][4 * (kb & 3) + 0] * inv * bflo(gq.z), o[kb >> 2][4 * (kb & 3) + 1] * inv * bfhi(gq.z)); ob.y = cvtpk(o[kb >> 2][4 * (kb & 3) + 2] * inv * bflo(gq.w), o[kb >> 2][4 * (kb & 3) + 3] * inv * bfhi(gq.w)); \
            { auto t0 = __builtin_amdgcn_permlane32_swap(oa.x, ob.x, false, false); oa.x = t0[0]; ob.x = t0[1]; auto t1 = __builtin_amdgcn_permlane32_swap(oa.y, ob.y, false, false); oa.y = t1[0]; ob.y = t1[1]; } \
            *(GAS v4u*)(YA + (size_t)(q0w + r) * (2 * DM) + head * HD + 16 * p + 8 * hh) = (v4u){oa.x, oa.y, ob.x, ob.y}; } } while (0)
    __syncthreads();
    ATT_LOAD((int)blockIdx.x); ATT_WRITE(0);
    LAS float* SK = (LAS float*)(base + 2 * ABUF);
    if (tid < NQH) SK[tid] = a.in[13][tid];
    bf16x8 bqA[4], bqB[4];
    ATT_Q(0, 0, bqA);
    __syncthreads();
#pragma unroll 1
    for (int it = 0; it < nloc; ++it) {
        const bool has_next = (it + 1) < nloc;
        if (has_next) ATT_LOAD((it + 1) * G + (int)blockIdx.x);
        ATT_Q(it, 1, bqB);
        __builtin_amdgcn_sched_barrier(0);
        ATT_TASK(it, 0, bqA);
        __builtin_amdgcn_sched_barrier(0);
        if (has_next) ATT_Q(it + 1, 0, bqA);
        __builtin_amdgcn_sched_barrier(0);
        ATT_TASK(it, 1, bqB);
        __builtin_amdgcn_sched_barrier(0);
        if (has_next) ATT_WRITE((it + 1) & 1);
        __syncthreads();
    }
    if (I8A && G == SEQ / 64) {
        __builtin_amdgcn_fence(__ATOMIC_RELEASE, "workgroup"); __syncthreads(); __builtin_amdgcn_fence(__ATOMIC_ACQUIRE, "workgroup");
        unsigned char* yb = (unsigned char*)(a.ws + WS_Y2) + 2 * DM; GAS float* RSo = (GAS float*)(F.ctl + CW_RS2);
        const int m0 = 64 * (int)blockIdx.x + 8 * w;
        v4u rawA[8], rawB[8];
        quant_row4096_load(rawA, yb + (size_t)m0 * (4 * DM), lane);
#pragma unroll 1
        for (int i = 0; i < 8; i += 2) {
            quant_row4096_load(rawB, yb + (size_t)(m0 + i + 1) * (4 * DM), lane);
            __builtin_amdgcn_sched_barrier(0);
            { const float sc = quant_row4096_finish(rawA, yb + (size_t)(m0 + i) * (4 * DM), lane); if (lane == 0) RSo[m0 + i] = sc; }
            if (i + 2 < 8) quant_row4096_load(rawA, yb + (size_t)(m0 + i + 2) * (4 * DM), lane);
            __builtin_amdgcn_sched_barrier(0);
            { const float sc = quant_row4096_finish(rawB, yb + (size_t)(m0 + i + 1) * (4 * DM), lane); if (lane == 0) RSo[m0 + i + 1] = sc; }
        }
    }
#undef ATT_LOAD
#undef ATT_WRITE
#undef ATT_Q
#undef ATT_TASK
}

#if defined(SCAN_NAIVE)
__device__ __forceinline__ void scan_naive(Frame& F, const Args& a) {
    LAS float* UL = (LAS float*)(F.lds + RING_OFF);
    const bf16* U = (const bf16*)(a.ws + WS_U); const bf16* Gr = (const bf16*)(a.ws + WS_G); bf16* Y = (bf16*)(a.ws + WS_Y2);
    const int cb = blockIdx.x, j = F.tid;
    if (cb >= NCB) return;
    const int ch = cb * CBW + (j & 255);
    const float* Wa = a.in[8] + (size_t)cb * 65536; const float* Wx = a.in[10] + (size_t)cb * 65536;
    const float ba = a.in[9][ch], bx = a.in[11][ch]; const float sp = log1pf(expf(-a.in[12][ch]));
    const float w0 = a.in[6][0 * DM + ch], w1 = a.in[6][1 * DM + ch], w2 = a.in[6][2 * DM + ch], w3 = a.in[6][3 * DM + ch], cbias = a.in[7][ch];
    float h = 0.f, u0 = 0.f, u1 = 0.f, u2 = 0.f;
    for (int t = 0; t < SEQ; ++t) {
        const float u3 = __builtin_bit_cast(float, (unsigned)U[(size_t)t * DM + ch] << 16);
        const float uc = cbias + w0 * u0 + w1 * u1 + w2 * u2 + w3 * u3; u0 = u1; u1 = u2; u2 = u3;
        __syncthreads();
        if (j < 256) UL[j] = uc;
        __syncthreads();
        if (j < 256) {
            float sa = 0.f, sx = 0.f;
            for (int k = 0; k < 256; ++k) { const float uk = UL[k]; sa += uk * Wa[k * 256 + j]; sx += uk * Wx[k * 256 + j]; }
            const float r = 1.0f / (1.0f + expf(-(sa + ba))), ii = 1.0f / (1.0f + expf(-(sx + bx)));
            const float la = -8.0f * r * sp; const float aa = expf(la);
            h = aa * h + sqrtf(-expm1f(2.0f * la)) * (ii * uc);
            const float g = __builtin_bit_cast(float, (unsigned)Gr[(size_t)t * DM + ch] << 16);
            Y[(size_t)t * (2 * DM) + ch] = (bf16)(cvtpk(h * g, 0.f) & 0xffffu);
        }
    }
}
#endif
#if defined(ATTN_NAIVE)
__device__ __forceinline__ void attn_naive(Frame& F, const Args& a) {
    const int lane = F.lane; const int gw = F.vcu * NWAVES + F.wave, NGW = F.G * NWAVES;
    const bf16* Q = (const bf16*)(a.ws + WS_Q); const bf16* Kg = (const bf16*)(a.ws + WS_K); const bf16* Vg = (const bf16*)(a.ws + WS_V); const bf16* GA = (const bf16*)(a.ws + WS_GA);
    bf16* YA = (bf16*)(a.ws + WS_Y2) + DM;
    for (int task = gw; task < SEQ * NQH; task += NGW) {
        const int t = task >> 6, head = task & 63, hk = head >> 3;
        const float sink2 = a.in[13][head] * LOG2E;
        float s[2];
#pragma unroll
        for (int e = 0; e < 2; ++e) { const int kp = t - 127 + 64 * e + lane; float acc = -__builtin_inff();
            if (kp >= 0) { acc = 0.f; for (int d = 0; d < HD; ++d) { const float qv = __builtin_bit_cast(float, (unsigned)Q[(size_t)t * DM + head * HD + d] << 16), kv = __builtin_bit_cast(float, (unsigned)Kg[(size_t)kp * DKV + hk * HD + d] << 16); acc += qv * kv; } }
            s[e] = acc; }
        float m = fmaxf(s[0], s[1]);
#pragma unroll
        for (int o = 1; o < 64; o <<= 1) m = fmaxf(m, __shfl_xor(m, o));
        m = fmaxf(m, sink2);
        const float p0 = __builtin_amdgcn_exp2f(s[0] - m), p1 = __builtin_amdgcn_exp2f(s[1] - m);
        const float l = wave_sum(p0 + p1) + __builtin_amdgcn_exp2f(sink2 - m);
        float o = 0.f;
        for (int i = 0; i < 64; ++i) { const float pa = __shfl(p0, i), pb = __shfl(p1, i); const int ka = t - 127 + i, kb = t - 63 + i;
            if (ka >= 0) o += pa * __builtin_bit_cast(float, (unsigned)Vg[(size_t)ka * DKV + hk * HD + lane] << 16);
            if (kb >= 0) o += pb * __builtin_bit_cast(float, (unsigned)Vg[(size_t)kb * DKV + hk * HD + lane] << 16); }
        const float g = __builtin_bit_cast(float, (unsigned)GA[(size_t)t * DM + head * HD + lane] << 16);
        YA[(size_t)t * (2 * DM) + head * HD + lane] = (bf16)(cvtpk(o / l * g, 0.f) & 0xffffu);
    }
}
#endif


#if defined(CHECK_G1)
__device__ __forceinline__ void check_g1(Frame& F, const Args& a) {
    const int gw = F.vcu * NWAVES + F.wave, lane = F.lane;
    const bf16* H = (const bf16*)(a.ws + WS_H); const bf16* U = (const bf16*)(a.ws + WS_U);
    float* acc = (float*)(F.ctl + CW_MOD) + 40000;
    const int row = (gw * 8191 + 37) % SEQ, col = (gw * 1021 + 5) % DM;
    double s = 0.0;
    for (int k = lane; k < DM; k += 64) s += (double)__builtin_bit_cast(float, (unsigned)H[(size_t)row * DM + k] << 16) * (double)a.in[5][(size_t)k * DIN + col];
#pragma unroll
    for (int o = 1; o < 64; o <<= 1) s += __shfl_xor(s, o);
    if (lane == 0) { const double got = (double)__builtin_bit_cast(float, (unsigned)U[(size_t)row * DM + col] << 16); const double e = got - s;
        atomicAdd(acc + 0, (float)(e * e)); atomicAdd(acc + 1, (float)(s * s)); }
}
#endif


#if defined(CHECK_MRG) || defined(CHECK_OUT)
__device__ __forceinline__ double bf2d(bf16 v) { return (double)__builtin_bit_cast(float, (unsigned)v << 16); }
__device__ __forceinline__ double wsum_d(double s) {
#pragma unroll
    for (int o = 1; o < 64; o <<= 1) s += __shfl_xor(s, o);
    return s; }
#endif
#if defined(CHECK_MRG)
__device__ __forceinline__ void check_mrg(Frame& F, const Args& a) {
    const int gw = F.vcu * NWAVES + F.wave, lane = F.lane;
    const bf16* YR = (const bf16*)(a.ws + WS_H); const bf16* YA = (const bf16*)(a.ws + WS_YA); const bf16* MR = (const bf16*)(a.ws + WS_MR); const bf16* MA = (const bf16*)(a.ws + WS_MA); const bf16* MG = (const bf16*)(a.ws + WS_MRG);
    float* acc = (float*)(F.ctl + CW_MOD) + 40000;
    const int row = (gw * 8191 + 37) % SEQ, col = (gw * 1021 + 5) % DM;
    double s1 = 0.0, s2 = 0.0;
    for (int k = lane; k < DM; k += 64) { s1 += bf2d(YR[(size_t)row * DM + k]) * (double)a.in[14][(size_t)k * DM + col]; s2 += bf2d(YA[(size_t)row * DM + k]) * (double)a.in[15][(size_t)k * DM + col]; }
    s1 = wsum_d(s1); s2 = wsum_d(s2);
    if (lane == 0) { const double ref = bf2d(MR[(size_t)row * DM + col]) * s1 + bf2d(MA[(size_t)row * DM + col]) * s2, got = bf2d(MG[(size_t)row * DM + col]), e = got - ref;
        atomicAdd(acc + 0, (float)(e * e)); atomicAdd(acc + 1, (float)(ref * ref)); }
}
#endif
#if defined(CHECK_OUT)
__device__ __forceinline__ void check_out(Frame& F, const Args& a) {
    const int gw = F.vcu * NWAVES + F.wave, lane = F.lane;
    const bf16* MG = (const bf16*)(a.ws + WS_MRG); const float* gate = (const float*)(F.ctl + CW_MOD) + 2 * DM;
    float* acc = (float*)(F.ctl + CW_MOD) + 40000;
    const int row = (gw * 8191 + 37) % SEQ, col = (gw * 1021 + 5) % DM;
    double s1 = 0.0;
    for (int k = lane; k < DM; k += 64) s1 += bf2d(MG[(size_t)row * DM + k]) * (double)a.in[16][(size_t)k * DM + col];
    s1 = wsum_d(s1);
    if (lane == 0) { const double ref = (double)gate[col] * s1, got = (double)a.out[(size_t)row * DM + col] - (double)a.in[0][(size_t)row * DM + col], e = got - ref;
        atomicAdd(acc + 0, (float)(e * e)); atomicAdd(acc + 1, (float)(ref * ref)); }
}
#endif


#if defined(CHECK_G1B)
__device__ __forceinline__ void check_g1b(Frame& F, const Args& a) {
    const int gw = F.vcu * NWAVES + F.wave, lane = F.lane;
    const bf16* H = (const bf16*)(a.ws + WS_H);
    float* acc = (float*)(F.ctl + CW_MOD) + 40000;
    constexpr int which = CHECK_G1B;
    constexpr int c0 = which == 1 ? 4096 : which == 2 ? 8192 : which == 3 ? 12288 : which == 4 ? 12800 : which == 5 ? 13312 : which == 6 ? 17408 : 21504;
    constexpr int wdt = (which == 3 || which == 4) ? 512 : 4096;
    const size_t off = which == 1 ? WS_G : which == 2 ? WS_Q : which == 3 ? WS_K : which == 4 ? WS_V : which == 5 ? WS_GA : which == 6 ? WS_MR : WS_MA;
    const bf16* T = (const bf16*)(a.ws + off);
    const int row = (gw * 8191 + 37) % SEQ, col = (gw * 1021 + 5) % wdt;
    double s = 0.0;
    for (int k = lane; k < DM; k += 64) s += (double)__builtin_bit_cast(float, (unsigned)H[(size_t)row * DM + k] << 16) * (double)a.in[5][(size_t)k * DIN + c0 + col];
#pragma unroll
    for (int o = 1; o < 64; o <<= 1) s += __shfl_xor(s, o);
    if (lane == 0) { double ref = s; if (which == 1 || which == 5) ref = s / (1.0 + exp(-s)); if (which == 6 || which == 7) ref = 1.0 / (1.0 + exp(-s)); if (which == 2) ref = s * 0.125 * 1.4426950408889634;
        const double got = (double)__builtin_bit_cast(float, (unsigned)T[(size_t)row * wdt + col] << 16); const double e = got - ref;
        atomicAdd(acc + 0, (float)(e * e)); atomicAdd(acc + 1, (float)(ref * ref)); }
}
#endif


#if defined(CHECK_H)
__device__ __forceinline__ void check_h(Frame& F, const Args& a) {
    const int gw = F.vcu * NWAVES + F.wave, lane = F.lane;
    const bf16* H = (const bf16*)(a.ws + WS_H); const float* mod = (const float*)(F.ctl + CW_MOD);
    float* acc = (float*)(F.ctl + CW_MOD) + 40000;
    const int row = (gw * 8191 + 37) % SEQ, col = (gw * 1021 + 5) % DM;
    double s = 0.0;
    for (int k = lane; k < DM; k += 64) { const double v = (double)a.in[0][(size_t)row * DM + k]; s += v * v; }
#pragma unroll
    for (int o = 1; o < 64; o <<= 1) s += __shfl_xor(s, o);
    if (lane == 0) { const double ref = (double)a.in[0][(size_t)row * DM + col] / sqrt(s / DM + 1e-6) * (double)a.in[4][col] * (1.0 + (double)mod[DM + col]) + (double)mod[col];
        const double got = (double)__builtin_bit_cast(float, (unsigned)H[(size_t)row * DM + col] << 16); const double e = got - ref;
        atomicAdd(acc + 0, (float)(e * e)); atomicAdd(acc + 1, (float)(ref * ref)); }
}
#endif

__device__ __forceinline__ void p7_final(Frame& F, const Args& a) {
    LAS float* FG = (LAS float*)(F.lds + RING_OFF);
    for (int d = F.tid; d < DM; d += NWAVES * 64) FG[d] = a.in[17][d];
    __syncthreads();
    const int gw = F.vcu * NWAVES + F.wave, NGW = F.G * NWAVES;
    const bf16* GO = (const bf16*)(a.ws + WS_GO);
#pragma unroll 1
    for (int m = gw; m < SEQ; m += NGW) {
        asm volatile("" ::: "memory");
        const GAS f32x4* xr = (const GAS f32x4*)(a.in[0] + (size_t)m * DM) + F.lane; const GAS v2u* gr = (const GAS v2u*)(GO + (size_t)m * DM) + F.lane;
        GAS f32x4* orow = (GAS f32x4*)(a.out + (size_t)m * DM) + F.lane;
        f32x4 v[16]; float s = 0.f;
#pragma unroll
        for (int j = 0; j < 16; ++j) { const v2u g = __builtin_nontemporal_load(gr + 64 * j); v[j] = __builtin_nontemporal_load(xr + 64 * j) + (f32x4){bflo(g.x), bfhi(g.x), bflo(g.y), bfhi(g.y)}; s += (v[j].x * v[j].x + v[j].y * v[j].y) + (v[j].z * v[j].z + v[j].w * v[j].w); }
        const float rstd = 1.0f / sqrtf(wave_sum(s) * (1.0f / DM) + EPS);
#pragma unroll
        for (int j = 0; j < 16; ++j) { const f32x4 g = *(const LAS f32x4*)(FG + 4 * F.lane + 256 * j); __builtin_nontemporal_store(v[j] * rstd * g, orow + 64 * j); }
    }
}

#ifndef SCAN_AT16
#define SCAN_TWOPASS 1
#endif
#ifndef SCAN_STORED
#define SCAN_RECOMPUTE 1
#endif
#ifndef GEMM_ALIGN
#define GEMM_ALIGN true
#endif
#ifndef GEMM_SP2
#define GEMM_SP2 true
#endif
#ifndef REP_P2
#define REP_P2 1
#endif
#ifndef REP_P5
#define REP_P5 1
#endif
#ifndef REP_P6
#define REP_P6 1
#endif
#ifndef REP_P3
#define REP_P3 1
#endif
#ifndef REP_P1
#define REP_P1 1
#endif
__global__ void __launch_bounds__(NWAVES * 64, 2) fwd(Args args) {
    extern __shared__ __attribute__((aligned(16))) unsigned char lds[];
    Frame F;
    F.lds = (LAS unsigned char*)lds;
    F.MISC = (volatile LAS unsigned*)(F.lds + MISC_OFF);
    F.tid = threadIdx.x; F.lane = F.tid & 63; F.wave = __builtin_amdgcn_readfirstlane(F.tid >> 6);
    F.G = gridDim.x; { const int bx = blockIdx.x; F.vcu = (F.G % 8 == 0) ? (bx % 8) * (F.G / 8) + bx / 8 : bx; }
    F.ctl = (gu32*)(args.ws + WS_CTL);
    for (int u = F.tid; u < (LDS_BYTES - LDSCTL_OFF) / 4; u += NWAVES * 64) ((LAS unsigned*)(F.lds + LDSCTL_OFF))[u] = 0u;
    __syncthreads();
    XcdBarrier bar; bar.bar = (unsigned*)(F.ctl + CW_BAR); bar.x = 0; bar.st = nullptr;
    if (N_LAUNCHES == 1) bar = xcd_barrier_post((unsigned*)(F.ctl + CW_BAR), F.MISC + 8);
#define GRID_BAR(seam) do { if (N_LAUNCHES != 1) { if (F.tid == 0) __hip_atomic_store(F.ctl + CW_TMO, 0xBADBA0u | (unsigned)(seam), RLX_AGENT); } else { xcd_barrier(bar); } } while (0)
    const int lo = args.ph_lo, hi = args.ph_hi;
#ifndef PH_MASK
#define PH_MASK 0xff
#endif
#define IN(k) (((PH_MASK >> (k)) & 1) && lo <= (k) && (k) < hi)
#define BOTH(k) (IN(k) && IN((k) + 1))
    unsigned char* ws = args.ws;

    if (IN(0)) { p0_prologue(F, args, true);
#if defined(REP_P0)
        p0_prologue(F, args, false);
#endif
        if (BOTH(0)) GRID_BAR(0); }
    if (IN(1)) { for (int rep = 0; rep < REP_P1; ++rep) { __syncthreads(); p1_hrows(F, args); } if (BOTH(1)) GRID_BAR(1); }
#define DO_P2() { \
        __syncthreads(); \
        pg8::Gemm g{(const pg8::bf16_t*)(ws + WS_H), (const pg8::bf16_t*)(ws + WS_WIN), SEQ, DIN, DM}; pg8::StaticOrder S; S.init(SEQ, DIN, F.G, (int)blockIdx.x); \
        pg8::EpiProj E{(pg8::bf16_t*)(ws + WS_U), (pg8::bf16_t*)(ws + WS_G), (pg8::bf16_t*)(ws + WS_Q), (pg8::bf16_t*)(ws + WS_K), (pg8::bf16_t*)(ws + WS_V), (pg8::bf16_t*)(ws + WS_GA), (pg8::bf16_t*)(ws + WS_MR), (pg8::bf16_t*)(ws + WS_MA), QSCALE}; \
        if (F8Q == 1 || F8Q == 2) { g.A8 = ws + WS_H8; g.B8 = ws + WS_WQ8; if (F8Q == 1) { g.f8_mask = E.f8_mask = F8_MASK; E.f8inv = 1.0f / WQ8_SCALE; if (I8Q) { E.RS = (const float*)(F.ctl + CW_RS); E.CS = (const float*)(F.ctl + CW_CS); E.BIAS = (const float*)(F.ctl + CW_BIAS); } }     \
            pg8::gemm_phase_mixed<pg8::EpiProj, pg8::StaticOrder, (I8Q != 0)>(F.lds + RING_OFF, g, S, E); } \
        else pg8::gemm_phase<pg8::EpiProj, pg8::StaticOrder, GEMM_ALIGN, GEMM_SP2>(F.lds + RING_OFF, g, S, E); }
#if defined(PROBE_GEMM_K)
#ifndef PROBE_LD
#define PROBE_LD DM
#endif
#ifndef PROBE_AMASK
#define PROBE_AMASK 0x7fffffff
#define PROBE_BMASK 0x7fffffff
#endif
    if (IN(2)) { __syncthreads();
        pg8::Gemm g{(const pg8::bf16_t*)(ws + WS_H), (const pg8::bf16_t*)(ws + WS_WIN), SEQ, PROBE_GEMM_N, PROBE_GEMM_K, PROBE_LD, PROBE_AMASK, PROBE_BMASK}; pg8::StaticOrder S; S.init(SEQ, PROBE_GEMM_N, F.G, (int)blockIdx.x);
        pg8::EpiDummy E{(pg8::bf16_t*)(ws + WS_Y2)};
        pg8::gemm_phase<pg8::EpiDummy, pg8::StaticOrder, GEMM_ALIGN, GEMM_SP2>(F.lds + RING_OFF, g, S, E); }
#endif
    if (IN(2)) { DO_P2()
#if REP_P2 >= 2
        DO_P2()
#endif
        if (BOTH(2)) GRID_BAR(2);
    }
#if defined(CHECK_G1)
    if (IN(3)) check_g1(F, args);
#endif
#if defined(CHECK_G1B)
    if (IN(3)) check_g1b(F, args);
#endif
#if defined(CHECK_H)
    if (IN(3)) check_h(F, args);
#endif
#if defined(SCAN_NAIVE)
    if (IN(3)) { scan_naive(F, args); if (BOTH(3)) GRID_BAR(3); }
#else
#if defined(SCAN_DMA)
    if (IN(3)) { conv_pass(F, args); GRID_BAR(30); scan_dma<1, SCAN_DMA>(F, args, (float*)(ws + WS_AGG)); if (BOTH(3)) GRID_BAR(3); }
#elif defined(SCAN_TWOPASS)
    if (IN(3)) { for (int rep = 0; rep < REP_P3; ++rep) scan_pass<1>(F, args, (float*)(ws + WS_AGG));
#if defined(SCAN_PROBE)
        scan_pass<1, SCAN_PROBE>(F, args, (float*)(ws + WS_AGG + 512 * 1024));
#endif
        if (BOTH(3)) GRID_BAR(3); }
#else
    if (IN(3)) { conv_pass(F, args); if (BOTH(3)) GRID_BAR(3); }
#endif
#endif
    #if defined(ATTN_NAIVE)
    if (IN(4)) { scan_pass<2>(F, args, (float*)(ws + WS_AGG)); attn_naive(F, args);
#else
#if defined(SCAN_DMA)
    if (IN(4)) { scan_dma<2, SCAN_DMA>(F, args, (float*)(ws + WS_AGG)); attn_phase(F, args);
#elif defined(SCAN_TWOPASS)
#if defined(SCAN_RECOMPUTE)
    if (IN(4)) { scan_pass<2>(F, args, (float*)(ws + WS_AGG)); attn_phase(F, args);
#if defined(AT16_PROBE)
        conv_pass(F, args); GRID_BAR(40);
#if AT16_PROBE > 0
        scan_at16(F, args, (bf16*)(ws + WS_H), DM);
#endif
#endif
#else
    if (IN(4)) { scan_light(F, args); attn_phase(F, args);
#endif
#else
    if (IN(4)) { scan_at16(F, args, (bf16*)(ws + WS_Y2), 2 * DM); attn_phase(F, args);
#endif
#if defined(REP_ATT)
        attn_phase(F, args);
#endif
#endif
 if (BOTH(4)) GRID_BAR(4); }
#define DO_P5() { __syncthreads(); \
        pg8::Gemm g{(const pg8::bf16_t*)(ws + WS_Y2), (const pg8::bf16_t*)(ws + WS_WCAT), SEQ, DM, 2 * DM}; pg8::StaticOrder S; S.init(SEQ, DM, F.G, (int)blockIdx.x); \
        if (I8A) { pg8::EpiMergeT<true> E{(const pg8::bf16_t*)(ws + WS_MA), (const pg8::bf16_t*)(ws + WS_MR), (pg8::bf16_t*)(ws + WS_MRG), (const float*)(F.ctl + CW_RS2), (const float*)(F.ctl + CW_CS2)};     \
            pg8::gemm_phase_split<pg8::EpiMergeT<true>, pg8::StaticOrder>(F.lds + RING_OFF, g, S, E, DM / 128, DM / 64, (size_t)(2 * DM)); } \
        else { pg8::EpiMerge E{(const pg8::bf16_t*)(ws + WS_MR), (const pg8::bf16_t*)(ws + WS_MA), (pg8::bf16_t*)(ws + WS_MRG)}; \
        pg8::gemm_phase<pg8::EpiMerge, pg8::StaticOrder, GEMM_ALIGN, GEMM_SP2>(F.lds + RING_OFF, g, S, E); } }
    if (IN(5)) {
#if defined(P5_STAGGER)
        if ((blockIdx.x & 7) >= 4) { const unsigned long long t0 = __builtin_amdgcn_s_memrealtime(); while (__builtin_amdgcn_s_memrealtime() - t0 < (unsigned long long)(P5_STAGGER)) __builtin_amdgcn_s_sleep(8); }
#endif
        if (I8A && F.G != SEQ / 64) { p4q_rows(F, args); GRID_BAR(45); }
        DO_P5()
#if defined(REP_P5X)
        DO_P5()
#endif
        if (BOTH(5)) GRID_BAR(5);
    }
#if defined(MOD_NAIVE)
#define GATE_PTR ((const float*)(F.ctl + CW_MOD) + 3 * DM + 64 + 2 * DM)
#else
#define GATE_PTR ((const float*)(F.ctl + CW_MOD) + 2 * DM)
#endif
#define DO_P6() { __syncthreads(); \
        pg8::Gemm g{(const pg8::bf16_t*)(ws + WS_MRG), (const pg8::bf16_t*)(ws + WS_WOUT), SEQ, DM, DM}; pg8::StaticOrder S; S.init(SEQ, DM, F.G, (int)blockIdx.x); \
        pg8::EpiOut E{GATE_PTR, (pg8::bf16_t*)(ws + WS_GO)}; \
        pg8::gemm_phase<pg8::EpiOut, pg8::StaticOrder, GEMM_ALIGN, GEMM_SP2>(F.lds + RING_OFF, g, S, E); }
    if (IN(6)) {
#if defined(CHECK_MRG)
        check_mrg(F, args);
#endif
        DO_P6()
#if defined(REP_P6X)
        DO_P6()
#endif
        if (BOTH(6)) GRID_BAR(6);
    }
    if (IN(7)) { __syncthreads();
#if defined(CHECK_OUT)
        check_out(F, args); GRID_BAR(7);
#endif
        p7_final(F, args);
#if defined(CHECK_G1) || defined(CHECK_MRG) || defined(CHECK_OUT) || defined(CHECK_G1B) || defined(CHECK_H)
        if (blockIdx.x == 0 && F.tid == 0) { const float* acc = (const float*)(F.ctl + CW_MOD) + 40000; args.out[0] += 1.0e4f * sqrtf(acc[0] / acc[1]); }
#endif
    }
#undef IN
#undef BOTH
}

extern "C" void kernel_launch(void* const* d_in, const int* in_sizes, int n_in, void* d_out, int out_size, void* d_ws, size_t ws_size, hipStream_t stream) {
    static int grid = 0;
    if (grid == 0) {
        if (n_in != 18 || in_sizes[0] != SEQ * DM || out_size != SEQ * DM || ws_size < WS_END) { fprintf(stderr, "kernel_launch: unexpected shapes (n_in %d, in0 %d, out %d, ws %zu); nothing launched\n", n_in, n_in > 0 ? in_sizes[0] : -1, out_size, ws_size); grid = -1; return; }
        int dev = 0, cus = 0, per_cu = 0;
        if (hipGetDevice(&dev) != hipSuccess || hipDeviceGetAttribute(&cus, hipDeviceAttributeMultiprocessorCount, dev) != hipSuccess) { grid = -1; return; }
        if (hipFuncSetAttribute((const void*)fwd, hipFuncAttributeMaxDynamicSharedMemorySize, LDS_BYTES) != hipSuccess) { fprintf(stderr, "kernel_launch: hipFuncSetAttribute failed\n"); grid = -1; return; }
        if (hipOccupancyMaxActiveBlocksPerMultiprocessor(&per_cu, (const void*)fwd, NWAVES * 64, LDS_BYTES) != hipSuccess || per_cu < 1) fprintf(stderr, "kernel_launch: note: occupancy query reports %d workgroups per CU\n", per_cu);
        (void)hipGetLastError();
        grid = cus;
    }
    if (grid < 0) return;
    if (hipMemsetAsync((char*)d_ws + WS_CTL, 0, CTL_ZERO_BYTES, stream) != hipSuccess) return;
    Args a{};
    for (int i = 0; i < 18; ++i) a.in[i] = (const float*)d_in[i];
    a.out = (float*)d_out; a.ws = (unsigned char*)d_ws;
    if (N_LAUNCHES == 1) { a.ph_lo = 0; a.ph_hi = N_PHASES; hipLaunchKernelGGL(fwd, dim3(grid), dim3(NWAVES * 64), LDS_BYTES, stream, a); }
    else for (int li = 0; li < N_PHASES; ++li) { a.ph_lo = li; a.ph_hi = li + 1; hipLaunchKernelGGL(fwd, dim3(grid), dim3(NWAVES * 64), LDS_BYTES, stream, a); }
}
```
